# Optimizing an MI355X kernel written in HIP

```python
import jax, jax.numpy as jnp
from jax import lax
import numpy as np


D_MODEL = 2048
BATCH = 8
SEQ = 2048
DEPTH = 2

CHUNK = 64
N_MIXERS = 2
GLA_HEADS = 4
GLA_DK = D_MODEL // 2 // GLA_HEADS
GLA_DV = D_MODEL // GLA_HEADS
GLA_GATE_RANK = 16
GLA_TAU = 16.0
GLA_QK = GLA_HEADS * GLA_DK
GLA_IN_COLS = 2 * GLA_QK + 2 * D_MODEL + GLA_GATE_RANK
ATT_HEADS = 16
ATT_HD = D_MODEL // ATT_HEADS
LEFT_CHUNKS = 8
BAND_CHUNKS = LEFT_CHUNKS + 1
BAND = BAND_CHUNKS * CHUNK
REL_CLIP = 256
REL_SIZE = REL_CLIP + CHUNK
D_FF = 4 * D_MODEL
EPS = 1e-6
N_GLA = (DEPTH + 1) // 2
N_ATT = DEPTH // 2

kernel_name = 'hybrid_gla_chunk_relattn_encoder'


def rmsnorm(x, g):
    xf = x.astype(jnp.float32)
    y = xf * lax.rsqrt(jnp.mean(xf * xf, axis=-1, keepdims=True) + EPS)
    return (y * g.astype(jnp.float32)).astype(x.dtype)


def gla_mixer(h, w_in, w_gate_up, b_gate, g_out, w_out):
    B, S, _ = h.shape
    N = S // CHUNK
    f32 = jnp.float32
    proj = h @ w_in
    q, k, v, r, z = jnp.split(proj, [GLA_QK, 2 * GLA_QK, 2 * GLA_QK + D_MODEL, 2 * GLA_QK + 2 * D_MODEL], axis=-1)
    logit = (z @ w_gate_up + b_gate).astype(f32)
    log_a = jax.nn.log_sigmoid(logit) / GLA_TAU

    def heads(t, d):
        return t.astype(f32).reshape(B, N, CHUNK, GLA_HEADS, d).transpose(0, 1, 3, 2, 4)

    qh = heads(q, GLA_DK) * (GLA_DK ** -0.5)
    kh = heads(k, GLA_DK)
    vh = heads(v, GLA_DV)
    b = jnp.cumsum(heads(log_a, GLA_DK), axis=3)
    b_last = b[:, :, :, -1:, :]
    q_dec = qh * jnp.exp(b)
    k_inv = kh * jnp.exp(-b)
    k_end = kh * jnp.exp(b_last - b)
    chunk_decay = jnp.exp(b_last[:, :, :, 0, :])

    causal = jnp.tril(jnp.ones((CHUNK, CHUNK), dtype=bool))
    A = jnp.where(causal, jnp.einsum('bnhcd,bnhsd->bnhcs', q_dec, k_inv), 0.0)
    o_intra = jnp.einsum('bnhcs,bnhsv->bnhcv', A, vh)

    def step(state, inp):
        q_n, k_n, v_n, dec_n = inp
        o_n = jnp.einsum('bhcd,bhdv->bhcv', q_n, state)
        state = dec_n[..., None] * state + jnp.einsum('bhcd,bhcv->bhdv', k_n, v_n)
        return state, o_n

    s0 = jnp.zeros((B, GLA_HEADS, GLA_DK, GLA_DV), f32)
    mv = lambda t: jnp.moveaxis(t, 1, 0)
    _, o_inter = lax.scan(step, s0, (mv(q_dec), mv(k_end), mv(vh), mv(chunk_decay)))
    o = o_intra + jnp.moveaxis(o_inter, 0, 1)
    o = o.transpose(0, 1, 3, 2, 4).reshape(B, S, GLA_HEADS, GLA_DV)
    o = o * lax.rsqrt(jnp.mean(o * o, axis=-1, keepdims=True) + EPS)
    o = o.reshape(B, S, D_MODEL) * g_out.astype(f32)
    o = o * jax.nn.silu(r.astype(f32))
    return (o.astype(h.dtype) @ w_out).astype(h.dtype)


def chunk_relattn_mixer(h, w_in, g_q, g_k, rel_bias, w_out):
    B, S, _ = h.shape
    N = S // CHUNK
    f32 = jnp.float32
    q, k, v = jnp.split(h @ w_in, 3, axis=-1)
    q = rmsnorm(q.reshape(B, S, ATT_HEADS, ATT_HD), g_q) * (ATT_HD ** -0.5)
    k = rmsnorm(k.reshape(B, S, ATT_HEADS, ATT_HD), g_k)
    v = v.reshape(B, S, ATT_HEADS, ATT_HD)
    pad = LEFT_CHUNKS * CHUNK
    kp = jnp.pad(k, ((0, 0), (pad, 0), (0, 0), (0, 0)))
    vp = jnp.pad(v, ((0, 0), (pad, 0), (0, 0), (0, 0)))
    c_idx = jnp.arange(CHUNK)[:, None]
    m_idx = jnp.arange(BAND)[None, :]
    dist = pad + c_idx - m_idx
    rel_idx = jnp.clip(dist, -(CHUNK - 1), REL_CLIP) + (CHUNK - 1)
    bias = rel_bias[:, rel_idx].astype(f32)
    key_pos = jnp.arange(BAND)
    qc = jnp.moveaxis(q.reshape(B, N, CHUNK, ATT_HEADS, ATT_HD), 1, 0)

    def one_chunk(args):
        q_n, n = args
        k_n = lax.dynamic_slice_in_dim(kp, n * CHUNK, BAND, axis=1)
        v_n = lax.dynamic_slice_in_dim(vp, n * CHUNK, BAND, axis=1)
        s = jnp.einsum('bchd,bmhd->bhcm', q_n, k_n).astype(f32) + bias
        valid = key_pos >= (LEFT_CHUNKS - n) * CHUNK
        s = jnp.where(valid, s, -jnp.inf)
        p = jax.nn.softmax(s, axis=-1)
        return jnp.einsum('bhcm,bmhd->bchd', p.astype(v_n.dtype), v_n)

    out = lax.map(one_chunk, (qc, jnp.arange(N)))
    out = jnp.moveaxis(out, 0, 1).reshape(B, S, D_MODEL)
    return (out @ w_out).astype(h.dtype)


def sqrelu_mlp(h, w_up, w_down):
    return jnp.square(jax.nn.relu(h @ w_up)) @ w_down


def setup_inputs(seed: int = 0) -> dict:
    key = jax.random.key(seed)
    ks = jax.random.split(key, 16)
    f32 = jnp.float32

    def nrm(k, shape, scale):
        return jax.random.normal(k, shape, f32) * scale

    return {
        'x': nrm(ks[0], (BATCH, SEQ, D_MODEL), 1.0),
        'norm_mix_g': 1.0 + nrm(ks[1], (DEPTH, D_MODEL), 0.02),
        'norm_mlp_g': 1.0 + nrm(ks[2], (DEPTH, D_MODEL), 0.02),
        'gla_w_in': nrm(ks[3], (N_GLA, D_MODEL, GLA_IN_COLS), D_MODEL ** -0.5),
        'gla_w_gate_up': nrm(ks[4], (N_GLA, GLA_GATE_RANK, GLA_QK), GLA_GATE_RANK ** -0.5),
        'gla_b_gate': nrm(ks[5], (N_GLA, GLA_QK), 0.1),
        'gla_g_out': 1.0 + nrm(ks[6], (N_GLA, D_MODEL), 0.02),
        'gla_w_out': nrm(ks[7], (N_GLA, D_MODEL, D_MODEL), D_MODEL ** -0.5),
        'att_w_in': nrm(ks[8], (N_ATT, D_MODEL, 3 * D_MODEL), D_MODEL ** -0.5),
        'att_g_q': 1.0 + nrm(ks[9], (N_ATT, ATT_HD), 0.02),
        'att_g_k': 1.0 + nrm(ks[10], (N_ATT, ATT_HD), 0.02),
        'att_rel_bias': nrm(ks[11], (N_ATT, ATT_HEADS, REL_SIZE), 0.2),
        'att_w_out': nrm(ks[12], (N_ATT, D_MODEL, D_MODEL), D_MODEL ** -0.5),
        'mlp_w_up': nrm(ks[13], (DEPTH, D_MODEL, D_FF), D_MODEL ** -0.5),
        'mlp_w_down': nrm(ks[14], (DEPTH, D_FF, D_MODEL), D_FF ** -0.5),
    }


def reference(x, norm_mix_g, norm_mlp_g, gla_w_in, gla_w_gate_up, gla_b_gate, gla_g_out, gla_w_out,
              att_w_in, att_g_q, att_g_k, att_rel_bias, att_w_out, mlp_w_up, mlp_w_down):
    for i in range(DEPTH):
        h = rmsnorm(x, norm_mix_g[i])
        j = i // N_MIXERS
        if i % N_MIXERS == 0:
            mix = gla_mixer(h, gla_w_in[j], gla_w_gate_up[j], gla_b_gate[j], gla_g_out[j], gla_w_out[j])
        else:
            mix = chunk_relattn_mixer(h, att_w_in[j], att_g_q[j], att_g_k[j], att_rel_bias[j], att_w_out[j])
        x = x + mix.astype(x.dtype)
        x = x + sqrelu_mlp(rmsnorm(x, norm_mlp_g[i]), mlp_w_up[i], mlp_w_down[i]).astype(x.dtype)
    return x
```

```cpp
#include <hip/hip_runtime.h>
#include <hip/hip_cooperative_groups.h>
#include <cstdio>
#include <cstdint>
namespace cg = cooperative_groups;

namespace pg8 {
#define PG8_LAS __attribute__((address_space(3)))
typedef unsigned short bf16_t;
typedef short bf16x8 __attribute__((ext_vector_type(8)));
typedef float f32x4 __attribute__((ext_vector_type(4)));
typedef unsigned u32x4 __attribute__((ext_vector_type(4)));
constexpr int BM = 256, BK = 64, HALF = 128, HTB = HALF * BK * 2  , STAGE_BYTES = 8 * HTB, NXCD = 8, WGM = 8;

__host__ __device__ __forceinline__ int lds_byte(int r, int c) { const int st = (r >> 4) * 2 + (c >> 5), rr = r & 15, cc = c & 31, ob = rr * 64 + cc * 2; return st * 1024 + (ob ^ (((ob >> 9) & 1) << 5)); }
__host__ __device__ __forceinline__ void stage_rc(int b, int& R, int& C) { const int st = b / 1024, sb = b % 1024, swz = sb ^ (((sb >> 9) & 1) << 5); R = (st >> 1) * 16 + swz / 64; C = (st & 1) * 32 + (swz % 64) / 2; }
__host__ __device__ __forceinline__ int perm32(int rho) { const int n = rho >> 4, i = rho & 15; return 8 * (i >> 2) + 4 * n + (i & 3); }

struct Unit { int pm, pn; };
struct Gemm { const bf16_t* A; const bf16_t* Bt; int M, N, K; int krev; };

struct StaticOrder {
    int nM, nN, nwg, G, c, wgm;
    __host__ __device__ void init(int M, int N, int G_, int c_, int wgm_ = WGM) { nM = M / BM; nN = N / BM; nwg = nM * nN; G = G_; c = c_; wgm = wgm_; }
    __host__ __device__ bool next(int i, Unit& u) const {
        const long L = (long)i * G + c; if (L >= nwg) return false;
        int wgid = (int)L; { const int q = nwg / NXCD, r = nwg % NXCD, xcd = wgid % NXCD, off = wgid / NXCD; wgid = (xcd < r ? xcd * (q + 1) : r * (q + 1) + (xcd - r) * q) + off; }
        const int nig = wgm * nN, gid = wgid / nig, fm = gid * wgm, gsz = (nM - fm) < wgm ? (nM - fm) : wgm;
        u.pm = fm + ((wgid % nig) % gsz); u.pn = (wgid % nig) / gsz; return true;
    }
    __device__ __forceinline__ void a_ready(const Unit&) const {}
    __device__ __forceinline__ void done(const Unit&) const {}
};

__device__ __forceinline__ unsigned cvt_pk_bf16(float lo, float hi) { unsigned r; asm volatile("v_cvt_pk_bf16_f32 %0, %1, %2" : "=v"(r) : "v"(lo), "v"(hi)); return r; }
typedef float f32x2 __attribute__((ext_vector_type(2)));
typedef unsigned u32x2 __attribute__((ext_vector_type(2)));
template <int ACT> struct EpiBf16S {
    static constexpr bool PERM = true, AFTER_DRAIN = false;
    bf16_t* O; int ldc; const float* ssq;
    __device__ __forceinline__ void operator()(const f32x4 (&acc)[2][2][4][2], const Unit& u, int wr, int wc, int fr, int fq) const {
        const int row0 = u.pm * BM + wr * 64 + fr; const int col0 = u.pn * BM + wc * 32 + 8 * fq;
        float sv[2][4];
#pragma unroll
        for (int ai = 0; ai < 2; ++ai)
#pragma unroll
            for (int m = 0; m < 4; ++m) sv[ai][m] = ssq[row0 + ai * HALF + m * 16];
        asm volatile("" ::: "memory");
#pragma unroll
        for (int ai = 0; ai < 2; ++ai)
#pragma unroll
            for (int m = 0; m < 4; ++m) {
                const int row = row0 + ai * HALF + m * 16;
                const float rs = __builtin_amdgcn_rsqf(sv[ai][m] * (1.0f / 2048.0f) + 1e-6f);
                bf16_t* rowp = O + (size_t)row * ldc + col0;
#pragma unroll
                for (int bj = 0; bj < 2; ++bj) {
                    f32x4 v0 = acc[ai][bj][m][0] * rs, v1 = acc[ai][bj][m][1] * rs;
                    if (ACT == 1) {
#pragma unroll
                        for (int e = 0; e < 4; ++e) { float a = fmaxf(v0[e], 0.f); v0[e] = a * a; float b = fmaxf(v1[e], 0.f); v1[e] = b * b; }
                    }
                    u32x4 w; w.x = cvt_pk_bf16(v0[0], v0[1]); w.y = cvt_pk_bf16(v0[2], v0[3]); w.z = cvt_pk_bf16(v1[0], v1[1]); w.w = cvt_pk_bf16(v1[2], v1[3]);
                    *(u32x4*)(rowp + bj * HALF) = w;
                }
            }
    }
};
struct EpiRes {
    static constexpr bool PERM = false, AFTER_DRAIN = false;
    bf16_t* xb; float* outf; float* ssq; int ldc; int fin;
    __device__ __forceinline__ void operator()(const f32x4 (&acc)[2][2][4][2], const Unit& u, int wr, int wc, int fr, int fq) const {
        const int row0 = u.pm * BM + wr * 64 + fr; const int col0 = u.pn * BM + wc * 32 + 4 * fq;
#pragma unroll
        for (int ai = 0; ai < 2; ++ai) {
            u32x2 bv[4][2][2];
#pragma unroll
            for (int m = 0; m < 4; ++m) { const size_t off = (size_t)(row0 + ai * HALF + m * 16) * ldc + col0;
#pragma unroll
                for (int bj = 0; bj < 2; ++bj)
#pragma unroll
                    for (int n = 0; n < 2; ++n) bv[m][bj][n] = *(const u32x2*)(xb + off + bj * HALF + n * 16); }
            asm volatile("" ::: "memory");
#pragma unroll
            for (int m = 0; m < 4; ++m) {
                const int row = row0 + ai * HALF + m * 16;
                const size_t off = (size_t)row * ldc + col0;
                float s = 0.f;
#pragma unroll
                for (int bj = 0; bj < 2; ++bj)
#pragma unroll
                    for (int n = 0; n < 2; ++n) {
                        const size_t c = off + bj * HALF + n * 16;
                        const u32x2 w0 = bv[m][bj][n];
                        const f32x4 b = {__uint_as_float(w0.x << 16), __uint_as_float(w0.x & 0xffff0000u), __uint_as_float(w0.y << 16), __uint_as_float(w0.y & 0xffff0000u)};
                        const f32x4 o = b + acc[ai][bj][m][n];
                        if (fin) { *(f32x4*)(outf + c) = o; }
                        else { u32x2 w; w.x = cvt_pk_bf16(o[0], o[1]); w.y = cvt_pk_bf16(o[2], o[3]); *(u32x2*)(xb + c) = w;
                               s += (o[0] * o[0] + o[1] * o[1]) + (o[2] * o[2] + o[3] * o[3]); }
                    }
                if (!fin) { s += __shfl_xor(s, 16); s += __shfl_xor(s, 32); if (fq == 0) unsafeAtomicAdd(ssq + row, s); }
            }
            asm volatile("" ::: "memory");
        }
    }
};

template <class Epi, class Sched, bool ALIGN_EPI = false, bool SP2 = false>
__device__ __forceinline__ void gemm_phase(PG8_LAS unsigned char* lds, const Gemm g, const Sched& S, const Epi& E) {
    int tid_ = threadIdx.x; asm volatile("" : "+v"(tid_));
    const int tid = tid_, wid = __builtin_amdgcn_readfirstlane(tid >> 6), lane = tid & 63, wr = wid >> 2, wc = wid & 3, fr = lane & 15, fq = lane >> 4;
    const int K = g.K, nt = K / BK;
    unsigned voffA[2], voffB[2];
#pragma unroll
    for (int i = 0; i < 2; ++i) { int R, C; stage_rc(tid * 16 + i * 8192, R, C); const int Rb = Epi::PERM ? ((R & ~31) + perm32(R & 31)) : R;
        voffA[i] = (unsigned)(R * K + C) * 2u; voffB[i] = (unsigned)(Rb * K + C) * 2u; }
    const long kstep = g.krev ? -(long)(BK * 2) : (long)(BK * 2);
    const size_t kbase = g.krev ? (size_t)(nt - 1) * (size_t)(BK * 2) : (size_t)0;
    const size_t hstep = (size_t)HALF * K * 2;
    const size_t tstep = 2 * hstep;
    const unsigned ldsw = (unsigned)wid * 1024u;
    const int aoff = lds_byte(wr * 64 + fr, fq * 8), boff = lds_byte(wc * 32 + fr, fq * 8);
#define PG8_SA(b, h) (((b) * 2 + (h)) * HTB)
#define PG8_SB(b, h) ((4 + (b) * 2 + (h)) * HTB)
#define PG8_STAGE(bufoff, gbase, voff) do { _Pragma("unroll") for (int _i = 0; _i < 2; ++_i) \
        __builtin_amdgcn_global_load_lds((const unsigned*)((const char*)(gbase) + (voff)[_i]), (PG8_LAS unsigned*)(lds + (bufoff) + ldsw + _i * 8192), 16, 0, 0); } while (0)
#define PG8_LDA(dst, b, h) do { _Pragma("unroll") for (int m = 0; m < 4; ++m) _Pragma("unroll") for (int k = 0; k < 2; ++k) dst[m][k] = *(const PG8_LAS bf16x8*)(lds + PG8_SA(b, h) + aoff + m * 2048 + k * 1024); } while (0)
#define PG8_LDB(dst, b, h) do { _Pragma("unroll") for (int n = 0; n < 2; ++n) _Pragma("unroll") for (int k = 0; k < 2; ++k) dst[n][k] = *(const PG8_LAS bf16x8*)(lds + PG8_SB(b, h) + boff + n * 2048 + k * 1024); } while (0)
#define PG8_MMA(ai, bj, At, Bt) do { __builtin_amdgcn_s_setprio(1); _Pragma("unroll") for (int m = 0; m < 4; ++m) _Pragma("unroll") for (int n = 0; n < 2; ++n) _Pragma("unroll") for (int k = 0; k < 2; ++k) \
        acc[ai][bj][m][n] = __builtin_amdgcn_mfma_f32_16x16x32_bf16(Bt[n][k], At[m][k], acc[ai][bj][m][n], 0, 0, 0); __builtin_amdgcn_s_setprio(0); } while (0)
#define PG8_WAIT_V(n) asm volatile("s_waitcnt vmcnt(" #n ")" ::: "memory")
#define PG8_WAIT_L(n) asm volatile("s_waitcnt lgkmcnt(" #n ")" ::: "memory")
#define PG8_BAR __builtin_amdgcn_s_barrier()
#define PG8_SCHED __builtin_amdgcn_sched_barrier(0)
    Unit cur, nxt; int ui = 0;
    if (!S.next(0, cur)) return;
    f32x4 acc[2][2][4][2];
#pragma unroll
    for (int a = 0; a < 2; ++a)
#pragma unroll
        for (int b = 0; b < 2; ++b)
#pragma unroll
            for (int m = 0; m < 4; ++m)
#pragma unroll
                for (int n = 0; n < 2; ++n) acc[a][b][m][n] = (f32x4){0.f, 0.f, 0.f, 0.f};
    bf16x8 At[4][2], B0[2][2], B1[2][2];
    const char* cA = (const char*)g.A + (size_t)cur.pm * tstep + kbase; const char* cB = (const char*)g.Bt + (size_t)cur.pn * tstep + kbase;
    S.a_ready(cur);
    if constexpr (SP2) {
        PG8_STAGE(PG8_SB(0, 0), cB, voffB); PG8_STAGE(PG8_SB(0, 1), cB + hstep, voffB); PG8_STAGE(PG8_SA(0, 0), cA, voffA); PG8_STAGE(PG8_SA(0, 1), cA + hstep, voffA);
        if (wr == 1) PG8_BAR;
        PG8_WAIT_V(2); PG8_BAR;
        PG8_STAGE(PG8_SB(1, 0), cB + kstep, voffB); PG8_STAGE(PG8_SA(1, 0), cA + kstep, voffA); PG8_STAGE(PG8_SB(1, 1), cB + hstep + kstep, voffB);
        PG8_WAIT_V(6); PG8_BAR;
    } else {
        PG8_STAGE(PG8_SB(0, 0), cB, voffB); PG8_STAGE(PG8_SA(0, 0), cA, voffA); PG8_STAGE(PG8_SB(0, 1), cB + hstep, voffB); PG8_STAGE(PG8_SA(0, 1), cA + hstep, voffA);
        if (wr == 1) PG8_BAR;
        PG8_WAIT_V(4); PG8_BAR;
        PG8_STAGE(PG8_SB(1, 0), cB + kstep, voffB); PG8_STAGE(PG8_SA(1, 0), cA + kstep, voffA); PG8_STAGE(PG8_SB(1, 1), cB + hstep + kstep, voffB);
        PG8_WAIT_V(6); PG8_BAR;
    }
    for (;;) {
        const bool has_next = S.next(ui + 1, nxt);
        const char* nA = has_next ? (const char*)g.A + (size_t)nxt.pm * tstep + kbase : cA; const char* nB = has_next ? (const char*)g.Bt + (size_t)nxt.pn * tstep + kbase : cB;
        for (int t = 0; t < nt; t += 2) {
            const bool last = (t == nt - 2);
            const char* a1 = cA + (long)(t + 1) * kstep;
            const char* a2 = last ? nA : cA + (long)(t + 2) * kstep; const char* b2 = last ? nB : cB + (long)(t + 2) * kstep;
            const char* a3 = a2 + kstep; const char* b3 = b2 + kstep;
            if (last && has_next) S.a_ready(nxt);
            if constexpr (SP2) {
            PG8_LDB(B0, 0, 0); PG8_LDB(B1, 0, 1); PG8_SCHED; PG8_LDA(At, 0, 0); PG8_STAGE(PG8_SA(1, 1), a1 + hstep, voffA);
            PG8_WAIT_V(8); PG8_WAIT_L(0); PG8_BAR; PG8_MMA(0, 0, At, B0); PG8_MMA(0, 1, At, B1); PG8_BAR; PG8_SCHED;
            PG8_LDA(At, 0, 1); PG8_STAGE(PG8_SB(0, 0), b2, voffB); PG8_STAGE(PG8_SB(0, 1), b2 + hstep, voffB); PG8_STAGE(PG8_SA(0, 0), a2, voffA);
            PG8_WAIT_V(8); PG8_WAIT_L(0); PG8_BAR; PG8_MMA(1, 0, At, B0); PG8_MMA(1, 1, At, B1); PG8_BAR; PG8_SCHED;
            PG8_LDB(B0, 1, 0); PG8_LDB(B1, 1, 1); PG8_SCHED; PG8_LDA(At, 1, 0); PG8_STAGE(PG8_SA(0, 1), a2 + hstep, voffA);
            PG8_WAIT_V(8); PG8_WAIT_L(0); PG8_BAR; PG8_MMA(0, 0, At, B0); PG8_MMA(0, 1, At, B1); PG8_BAR; PG8_SCHED;
            PG8_LDA(At, 1, 1); PG8_STAGE(PG8_SB(1, 0), b3, voffB); PG8_STAGE(PG8_SB(1, 1), b3 + hstep, voffB); PG8_STAGE(PG8_SA(1, 0), a3, voffA);
            PG8_WAIT_V(8); PG8_WAIT_L(0); PG8_BAR; PG8_MMA(1, 0, At, B0); PG8_MMA(1, 1, At, B1); PG8_BAR; PG8_SCHED;
            } else {
            PG8_LDB(B0, 0, 0); PG8_SCHED; PG8_LDA(At, 0, 0); PG8_STAGE(PG8_SA(1, 1), a1 + hstep, voffA);
            PG8_WAIT_L(8); PG8_BAR; PG8_WAIT_L(0); PG8_MMA(0, 0, At, B0); PG8_BAR; PG8_SCHED;
            PG8_LDB(B1, 0, 1); PG8_STAGE(PG8_SB(0, 0), b2, voffB);
            PG8_BAR; PG8_WAIT_L(0); PG8_MMA(0, 1, At, B1); PG8_BAR;
            PG8_LDA(At, 0, 1); PG8_STAGE(PG8_SA(0, 0), a2, voffA);
            PG8_BAR; PG8_WAIT_L(0); PG8_MMA(1, 0, At, B0); PG8_BAR; PG8_SCHED;
            PG8_STAGE(PG8_SB(0, 1), b2 + hstep, voffB);
            PG8_WAIT_V(6); PG8_BAR; PG8_MMA(1, 1, At, B1); PG8_BAR;
            PG8_LDB(B0, 1, 0); PG8_SCHED; PG8_LDA(At, 1, 0); PG8_STAGE(PG8_SA(0, 1), a2 + hstep, voffA);
            PG8_WAIT_L(8); PG8_BAR; PG8_WAIT_L(0); PG8_MMA(0, 0, At, B0); PG8_BAR; PG8_SCHED;
            PG8_LDB(B1, 1, 1); PG8_STAGE(PG8_SB(1, 0), b3, voffB);
            PG8_BAR; PG8_WAIT_L(0); PG8_MMA(0, 1, At, B1); PG8_BAR;
            PG8_LDA(At, 1, 1); PG8_STAGE(PG8_SA(1, 0), a3, voffA);
            PG8_BAR; PG8_WAIT_L(0); PG8_MMA(1, 0, At, B0); PG8_BAR; PG8_SCHED;
            PG8_STAGE(PG8_SB(1, 1), b3 + hstep, voffB);
            PG8_WAIT_V(6); PG8_BAR; PG8_MMA(1, 1, At, B1); PG8_BAR;
            }
        }
        if constexpr (ALIGN_EPI) { if (wr == 0) PG8_BAR; }
        if constexpr (!Epi::AFTER_DRAIN) { E(acc, cur, wr, wc, fr, fq);
#ifdef REP_EPI
            if constexpr (Epi::PERM) { asm volatile("" ::: "memory"); E(acc, cur, wr, wc, fr, fq); }
#endif
            S.done(cur); }
        if (!has_next) break;
#pragma unroll
        for (int a = 0; a < 2; ++a)
#pragma unroll
            for (int b = 0; b < 2; ++b)
#pragma unroll
                for (int m = 0; m < 4; ++m)
#pragma unroll
                    for (int n = 0; n < 2; ++n) acc[a][b][m][n] = (f32x4){0.f, 0.f, 0.f, 0.f};
        cur = nxt; cA = nA; cB = nB; ++ui;
        if constexpr (ALIGN_EPI) { if (wr == 1) PG8_BAR; }
    }
    PG8_WAIT_V(0);
    if constexpr (!ALIGN_EPI) { if (wr == 0) PG8_BAR; }
    PG8_BAR;
    if constexpr (Epi::AFTER_DRAIN) { E.fused(acc, cur, wr, wc, fr, fq, lds, wid, lane); S.done(cur); }
#undef PG8_SA
#undef PG8_SB
#undef PG8_STAGE
#undef PG8_LDA
#undef PG8_LDB
#undef PG8_MMA
#undef PG8_WAIT_V
#undef PG8_WAIT_L
#undef PG8_BAR
#undef PG8_SCHED
}
}

#define LAS __attribute__((address_space(3)))
typedef unsigned short bf16;
typedef unsigned v4u __attribute__((ext_vector_type(4)));
typedef unsigned v2u __attribute__((ext_vector_type(2)));
typedef float f32x4 __attribute__((ext_vector_type(4)));
typedef float f32x2 __attribute__((ext_vector_type(2)));
typedef short bf16x8 __attribute__((ext_vector_type(8)));
typedef short s16x4 __attribute__((ext_vector_type(4)));
typedef short v4i16_t __attribute__((ext_vector_type(4)));
typedef __bf16 bf16x2_t __attribute__((ext_vector_type(2)));

constexpr int M_TOK = 16384, DM = 2048, FF = 8192, NPROJ = 6144, GLA_LD = 6160;
constexpr float EPS = 1e-6f, LOG2E = 1.4426950408889634f;
constexpr size_t MiB = 1u << 20;
constexpr size_t WS_SSQ = 0;
constexpr size_t WS_HSSQ = 256 * 1024;
constexpr size_t WS_WZT = 512 * 1024;
constexpr size_t WS_QK0 = 576 * 1024;
constexpr size_t WS_BAR = 704 * 1024;
constexpr size_t WS_DEC = 1 * MiB;
constexpr size_t WS_WIN = 4 * MiB, WS_WO = 28 * MiB, WS_WUP = 36 * MiB, WS_WDN = 68 * MiB;
constexpr size_t WS_XB = 100 * MiB;
constexpr size_t WS_U = 164 * MiB;
constexpr size_t WS_PROJ = 164 * MiB;
constexpr size_t WS_OG = 356 * MiB;
constexpr size_t WS_HPART = 420 * MiB;
constexpr size_t WS_END = 428 * MiB;
constexpr int LDS_BYTES = 147456;

#define LDS_WAIT() asm volatile("s_waitcnt lgkmcnt(0)" ::: "memory")
#define LBAR() do { asm volatile("s_waitcnt lgkmcnt(0)" ::: "memory"); __builtin_amdgcn_s_barrier(); asm volatile("" ::: "memory"); } while (0)

__device__ __forceinline__ unsigned pk2(float lo, float hi) { f32x2 v = {lo, hi}; bf16x2_t b = __builtin_convertvector(v, bf16x2_t); return __builtin_bit_cast(unsigned, b); }
__device__ __forceinline__ unsigned short f2bf(float f) { return (unsigned short)(pk2(f, 0.f) & 0xffffu); }
__device__ __forceinline__ float bflo(unsigned u) { return __uint_as_float(u << 16); }
__device__ __forceinline__ float bfhi(unsigned u) { return __uint_as_float(u & 0xffff0000u); }
__device__ __forceinline__ float wave_sum(float v) {
#pragma unroll
    for (int o = 1; o < 64; o <<= 1) v += __shfl_xor(v, o);
    return v;
}
__device__ __forceinline__ float dpp_sum16(float v) {
    v += __int_as_float(__builtin_amdgcn_update_dpp(0, __float_as_int(v), 0xB1, 0xF, 0xF, false));
    v += __int_as_float(__builtin_amdgcn_update_dpp(0, __float_as_int(v), 0x4E, 0xF, 0xF, false));
    v += __int_as_float(__builtin_amdgcn_update_dpp(0, __float_as_int(v), 0x141, 0xF, 0xF, false));
    v += __int_as_float(__builtin_amdgcn_update_dpp(0, __float_as_int(v), 0x140, 0xF, 0xF, false));
    return v;
}
__device__ __forceinline__ float xrow_sum(float v) {
    auto a = __builtin_amdgcn_permlane16_swap(__float_as_uint(v), __float_as_uint(v), false, false);
    v = __uint_as_float(a[0]) + __uint_as_float(a[1]);
    auto b = __builtin_amdgcn_permlane32_swap(__float_as_uint(v), __float_as_uint(v), false, false);
    return __uint_as_float(b[0]) + __uint_as_float(b[1]);
}
__device__ __forceinline__ float xrow_max(float v) {
    auto a = __builtin_amdgcn_permlane16_swap(__float_as_uint(v), __float_as_uint(v), false, false);
    v = fmaxf(__uint_as_float(a[0]), __uint_as_float(a[1]));
    auto b = __builtin_amdgcn_permlane32_swap(__float_as_uint(v), __float_as_uint(v), false, false);
    return fmaxf(__uint_as_float(b[0]), __uint_as_float(b[1]));
}
__device__ __forceinline__ s16x4 tr_read(const LAS unsigned char* p) { return __builtin_bit_cast(s16x4, __builtin_amdgcn_ds_read_tr16_b64_v4i16((LAS v4i16_t*)p)); }
__device__ __forceinline__ bf16x8 cat8(s16x4 a, s16x4 b) { return (bf16x8){a[0], a[1], a[2], a[3], b[0], b[1], b[2], b[3]}; }
__device__ __forceinline__ bf16x8 pack8(f32x4 a, f32x4 b) { v4u w; w.x = pk2(a[0], a[1]); w.y = pk2(a[2], a[3]); w.z = pk2(b[0], b[1]); w.w = pk2(b[2], b[3]); return __builtin_bit_cast(bf16x8, w); }
#define MFMA16(a, b, c) __builtin_amdgcn_mfma_f32_16x16x32_bf16((a), (b), (c), 0, 0, 0)

struct ConvTile { const float* src; const float* gk; bf16* dst; int ldw, K; };
__device__ __forceinline__ ConvTile conv_tile(int t, const float* Win, int ldwin, const float* gmix, const float* Wo, const float* Wup, const float* gmlp, const float* Wdn, unsigned char* ws) {
    constexpr int T_IN = 16 * 48, T_O = 16 * 16, T_UP = 16 * 64;
    ConvTile c;
    if (t < T_IN) { const int kb = t / 48, nb = t % 48; c.src = Win + (size_t)(128 * kb) * ldwin + 128 * nb; c.gk = gmix + 128 * kb; c.dst = (bf16*)(ws + WS_WIN) + (size_t)(128 * nb) * 2048 + 128 * kb; c.ldw = ldwin; c.K = 2048; return c; }
    t -= T_IN;
    if (t < T_O) { const int kb = t / 16, nb = t % 16; c.src = Wo + (size_t)(128 * kb) * 2048 + 128 * nb; c.gk = nullptr; c.dst = (bf16*)(ws + WS_WO) + (size_t)(128 * nb) * 2048 + 128 * kb; c.ldw = 2048; c.K = 2048; return c; }
    t -= T_O;
    if (t < T_UP) { const int kb = t / 64, nb = t % 64; c.src = Wup + (size_t)(128 * kb) * 8192 + 128 * nb; c.gk = gmlp + 128 * kb; c.dst = (bf16*)(ws + WS_WUP) + (size_t)(128 * nb) * 2048 + 128 * kb; c.ldw = 8192; c.K = 2048; return c; }
    t -= T_UP;
    { const int kb = t / 16, nb = t % 16; c.src = Wdn + (size_t)(128 * kb) * 2048 + 128 * nb; c.gk = nullptr; c.dst = (bf16*)(ws + WS_WDN) + (size_t)(128 * nb) * 8192 + 128 * kb; c.ldw = 2048; c.K = 8192; return c; }
}
__device__ __forceinline__ void convert_weights(const float* Win, int ldwin, const float* gmix, const float* Wo, const float* Wup, const float* gmlp, const float* Wdn,
                                                unsigned char* ws, LAS unsigned char* lds, int tid, int G) {
    asm volatile("" : "+v"(tid));
    constexpr int NT = 16 * 48 + 16 * 16 + 16 * 64 + 64 * 16;
    LAS float* scr = (LAS float*)lds;
    const int lr = tid >> 5, lc = (tid & 31) * 4;
    const int oc = tid & 15, on = tid >> 4;
    f32x4 r[8]; float gv[8];
    int t = blockIdx.x;
    if (t < NT) { const ConvTile c = conv_tile(t, Win, ldwin, gmix, Wo, Wup, gmlp, Wdn, ws);
#pragma unroll
        for (int i = 0; i < 8; ++i) { r[i] = __builtin_nontemporal_load((const f32x4*)(c.src + (size_t)(lr + 16 * i) * c.ldw + lc)); gv[i] = c.gk ? c.gk[lr + 16 * i] : 1.f; } }
    for (; t < NT; t += G) {
        const ConvTile c = conv_tile(t, Win, ldwin, gmix, Wo, Wup, gmlp, Wdn, ws);
        __syncthreads();
#pragma unroll
        for (int i = 0; i < 8; ++i) { LAS float* p = scr + (lr + 16 * i) * 129 + lc; p[0] = r[i][0] * gv[i]; p[1] = r[i][1] * gv[i]; p[2] = r[i][2] * gv[i]; p[3] = r[i][3] * gv[i]; }
        __syncthreads();
        if (t + G < NT) { const ConvTile cn = conv_tile(t + G, Win, ldwin, gmix, Wo, Wup, gmlp, Wdn, ws);
#pragma unroll
            for (int i = 0; i < 8; ++i) { r[i] = __builtin_nontemporal_load((const f32x4*)(cn.src + (size_t)(lr + 16 * i) * cn.ldw + lc)); gv[i] = cn.gk ? cn.gk[lr + 16 * i] : 1.f; } }
#pragma unroll
        for (int i = 0; i < 4; ++i) { const int n = on + 32 * i; const LAS float* sp = scr + (8 * oc) * 129 + n;
            v4u o; o.x = pk2(sp[0 * 129], sp[1 * 129]); o.y = pk2(sp[2 * 129], sp[3 * 129]); o.z = pk2(sp[4 * 129], sp[5 * 129]); o.w = pk2(sp[6 * 129], sp[7 * 129]);
            *(v4u*)(c.dst + (size_t)n * c.K + 8 * oc) = o; }
    }
    __syncthreads();
}

__device__ __forceinline__ float log_sigmoid(float x) { return fminf(x, 0.f) - __logf(1.f + __expf(-fabsf(x))); }
__device__ __forceinline__ void gla_prep(LAS unsigned char* lds, const bf16* xb, const bf16* WzT, const float* ssq0, const float* Wg, const float* bg, bf16* proj, float* dec,
                                         int tid, int lane, int w) {
    asm volatile("" : "+v"(tid), "+v"(lane)); asm volatile("" : "+s"(w));
    LAS float* zp = (LAS float*)lds;
    LAS float* zs = (LAS float*)(lds + 32768);
    const int g = lane >> 4, i16 = lane & 15;
    for (int unit = blockIdx.x; unit < 256; unit += gridDim.x) {
        const int tok0 = unit * 64;
        f32x4 za[4];
#pragma unroll
        for (int mt = 0; mt < 4; ++mt) za[mt] = (f32x4){0.f, 0.f, 0.f, 0.f};
#pragma unroll
        for (int ks = 0; ks < 8; ++ks) {
            const int k = w * 256 + ks * 32 + g * 8;
            const bf16x8 bf = *(const bf16x8*)(WzT + i16 * 2048 + k);
#pragma unroll
            for (int mt = 0; mt < 4; ++mt) { const bf16x8 af = *(const bf16x8*)(xb + (size_t)(tok0 + mt * 16 + i16) * 2048 + k); za[mt] = MFMA16(af, bf, za[mt]); }
        }
#pragma unroll
        for (int mt = 0; mt < 4; ++mt)
#pragma unroll
            for (int j = 0; j < 4; ++j) zp[(w * 64 + mt * 16 + 4 * g + j) * 16 + i16] = za[mt][j];
        __syncthreads();
#pragma unroll
        for (int e = 0; e < 2; ++e) { const int idx = tid + 512 * e, row = idx >> 4; float s = 0.f;
#pragma unroll
            for (int ww = 0; ww < 8; ++ww) s += zp[ww * 1024 + idx];
            zs[idx] = s * __builtin_amdgcn_rsqf(ssq0[tok0 + row] * (1.0f / 2048.0f) + EPS); }
        __syncthreads();
        const int c0 = 2 * tid;
        float wg0[16], wg1[16];
#pragma unroll
        for (int j = 0; j < 16; ++j) { const f32x2 t = *(const f32x2*)(Wg + j * 1024 + c0); wg0[j] = t.x; wg1[j] = t.y; }
        const f32x2 bgv = *(const f32x2*)(bg + c0);
        float b0 = 0.f, b1 = 0.f;
        unsigned* qp = (unsigned*)(proj + (size_t)tok0 * NPROJ + c0);
        unsigned q2[8], k2[8], q2n[8], k2n[8];
#pragma unroll
        for (int u = 0; u < 8; ++u) { const unsigned* p = qp + (size_t)u * (NPROJ / 2); q2[u] = p[0]; k2[u] = p[512]; }
        for (int t0 = 0; t0 < 64; t0 += 8) {
            if (t0 + 8 < 64) {
#pragma unroll
                for (int u = 0; u < 8; ++u) { const unsigned* p = qp + (size_t)(t0 + 8 + u) * (NPROJ / 2); q2n[u] = p[0]; k2n[u] = p[512]; }
            }
            asm volatile("" ::: "memory");
#pragma unroll
            for (int u = 0; u < 8; ++u) {
                const int t = t0 + u;
                float l0 = bgv.x, l1 = bgv.y;
#pragma unroll
                for (int j4 = 0; j4 < 4; ++j4) { const f32x4 z = *(const LAS f32x4*)(zs + t * 16 + j4 * 4);
#pragma unroll
                    for (int e = 0; e < 4; ++e) { l0 += z[e] * wg0[j4 * 4 + e]; l1 += z[e] * wg1[j4 * 4 + e]; } }
                b0 += log_sigmoid(l0) * (1.0f / 16.0f); b1 += log_sigmoid(l1) * (1.0f / 16.0f);
                unsigned* p = qp + (size_t)t * (NPROJ / 2);
                const float e0 = __expf(b0), e1 = __expf(b1), i0 = __expf(-b0), i1 = __expf(-b1);
                p[0] = pk2(bflo(q2[u]) * 0.0625f * e0, bfhi(q2[u]) * 0.0625f * e1);
                p[512] = pk2(bflo(k2[u]) * i0, bfhi(k2[u]) * i1);
            }
            asm volatile("" ::: "memory");
#pragma unroll
            for (int u = 0; u < 8; ++u) { q2[u] = q2n[u]; k2[u] = k2n[u]; }
        }
        *(f32x2*)(dec + (size_t)unit * 1024 + c0) = (f32x2){__expf(b0), __expf(b1)};
        __syncthreads();
    }
}

__device__ __forceinline__ void gla_scan(LAS unsigned char* lds, const bf16* proj, const float* dec, const float* qk0, bf16* og, float* hssq, int tid, int lane, int w) {
    asm volatile("" : "+v"(tid), "+v"(lane)); asm volatile("" : "+s"(w));
    constexpr int QS = 528, VS = 144, XS = 272;
    constexpr int QD = 0, KI = 33792, VV = 67584, AB = 76800, XO = 86016, DC = 103424;
    const int g = lane >> 4, i16 = lane & 15, dvt = w & 3, half = w >> 2;
    for (int unit = blockIdx.x; unit < 256; unit += gridDim.x) {
        const int xcd = unit & 7, uidx = unit >> 3, bh = xcd * 4 + (uidx >> 3), b = bh >> 2, h = bh & 3, js = uidx & 7;
        f32x4 S[8];
#pragma unroll
        for (int i = 0; i < 8; ++i) S[i] = (f32x4){0.f, 0.f, 0.f, 0.f};
        { float a00; const f32x4 q4 = *(const f32x4*)(qk0 + b * 2048 + h * 256 + lane * 4), k4 = *(const f32x4*)(qk0 + b * 2048 + 1024 + h * 256 + lane * 4);
          a00 = wave_sum((q4[0] * k4[0] + q4[1] * k4[1]) + (q4[2] * k4[2] + q4[3] * k4[3])) * 0.0625f;
          if (tid == 0) *(LAS float*)(lds + DC + 1024) = a00; }
        const int lrow = tid >> 5, lch = tid & 31, vrow = tid >> 3, vch = tid & 7;
        const bf16* pq = proj + (size_t)(b * 2048 + lrow) * NPROJ + h * 256 + lch * 8;
        const bf16* pv = proj + (size_t)(b * 2048 + vrow) * NPROJ + 2048 + h * 512 + js * 64 + vch * 8;
        const float* pd = dec + (size_t)(b * 32) * 1024 + h * 256 + (tid & 255);
        f32x4 ofin[4];
#pragma unroll
        for (int ct = 0; ct < 4; ++ct) ofin[ct] = (f32x4){0.f, 0.f, 0.f, 0.f};
#define SCAN_FLUSH(NP) do { const int tokb = b * 2048 + (NP) * 64; \
            _Pragma("unroll") for (int ct = 0; ct < 4; ++ct) _Pragma("unroll") for (int j = 0; j < 4; ++j) { \
                const int c = ct * 16 + 4 * g + j; const float v = ofin[ct][j]; \
                og[(size_t)(tokb + c) * DM + h * 512 + js * 64 + dvt * 16 + i16] = f2bf(v); \
                const float s = dpp_sum16(v * v); \
                if (i16 == 0) hssq[((size_t)(tokb + c) * 4 + h) * 32 + js * 4 + dvt] = s; } } while (0)
        v4u rq[4], rk[4], rv; float rd;
#pragma unroll
        for (int i = 0; i < 4; ++i) { rq[i] = *(const v4u*)(pq + (size_t)(16 * i) * NPROJ); rk[i] = *(const v4u*)(pq + (size_t)(16 * i) * NPROJ + 1024); }
        rv = *(const v4u*)pv; rd = pd[0];
        for (int n = 0; n < 32; ++n) {
            LBAR();
#pragma unroll
            for (int i = 0; i < 4; ++i) { *(LAS v4u*)(lds + QD + (lrow + 16 * i) * QS + lch * 16) = rq[i]; *(LAS v4u*)(lds + KI + (lrow + 16 * i) * QS + lch * 16) = rk[i]; }
            *(LAS v4u*)(lds + VV + vrow * VS + vch * 16) = rv;
            if (tid < 256) *(LAS float*)(lds + DC + tid * 4) = rd;
            LBAR();
            if (n + 1 < 32) {
                const size_t adv = (size_t)(n + 1) * 64 * NPROJ;
#pragma unroll
                for (int i = 0; i < 4; ++i) { rq[i] = *(const v4u*)(pq + adv + (size_t)(16 * i) * NPROJ); rk[i] = *(const v4u*)(pq + adv + (size_t)(16 * i) * NPROJ + 1024); }
                rv = *(const v4u*)(pv + adv); rd = pd[(n + 1) * 1024];
            }
            if (half == 0 && n > 0) { SCAN_FLUSH(n - 1); }
            {
                const int ct = w >> 1;
#pragma unroll
                for (int tt = 0; tt < 2; ++tt) {
                    const int st = (w & 1) * 2 + tt;
                    f32x4 a = (f32x4){0.f, 0.f, 0.f, 0.f};
                    if (st <= ct) {
                        bf16x8 af[8], bfr[8];
#pragma unroll
                        for (int ks = 0; ks < 8; ++ks) {
                            af[ks] = *(const LAS bf16x8*)(lds + QD + (ct * 16 + i16) * QS + ks * 64 + g * 16);
                            bfr[ks] = *(const LAS bf16x8*)(lds + KI + (st * 16 + i16) * QS + ks * 64 + g * 16);
                        }
                        asm volatile("" ::: "memory");
#pragma unroll
                        for (int ks = 0; ks < 8; ++ks) a = MFMA16(af[ks], bfr[ks], a);
                    }
#pragma unroll
                    for (int j = 0; j < 4; ++j) { const int c = ct * 16 + 4 * g + j, s = st * 16 + i16; float v = (s <= c) ? a[j] : 0.f;
                        if (n == 0 && c == 0 && s == 0) v = *(const LAS float*)(lds + DC + 1024);
                        *(LAS unsigned short*)(lds + AB + c * VS + s * 2) = f2bf(v); }
                }
            }
            f32x4 o[4];
#pragma unroll
            for (int ct = 0; ct < 4; ++ct) o[ct] = (f32x4){0.f, 0.f, 0.f, 0.f};
            {
                s16x4 qlo[4][4], qhi[4][4];
#pragma unroll
                for (int p = 0; p < 4; ++p) {
                    const int dkA = (half * 8 + 2 * p) * 16 + 4 * g;
#pragma unroll
                    for (int ct = 0; ct < 4; ++ct) {
                        qlo[p][ct] = *(const LAS s16x4*)(lds + QD + (ct * 16 + i16) * QS + dkA * 2);
                        qhi[p][ct] = *(const LAS s16x4*)(lds + QD + (ct * 16 + i16) * QS + (dkA + 16) * 2);
                    }
                }
                asm volatile("" ::: "memory");
#pragma unroll
                for (int p = 0; p < 4; ++p) {
                    const bf16x8 sf = pack8(S[2 * p], S[2 * p + 1]);
#pragma unroll
                    for (int ct = 0; ct < 4; ++ct) o[ct] = MFMA16(cat8(qlo[p][ct], qhi[p][ct]), sf, o[ct]);
                }
            }
            LBAR();
            bf16x8 vf0, vf1;
            { const LAS unsigned char* va = lds + VV + (8 * g + (i16 >> 2)) * VS + (dvt * 16 + 4 * (i16 & 3)) * 2;
              vf0 = cat8(tr_read(va), tr_read(va + 4 * VS)); vf1 = cat8(tr_read(va + 32 * VS), tr_read(va + 36 * VS)); }
            { const bf16x8 vh = half ? vf1 : vf0; bf16x8 af[4];
#pragma unroll
              for (int ct = 0; ct < 4; ++ct) af[ct] = *(const LAS bf16x8*)(lds + AB + (ct * 16 + i16) * VS + (half * 32 + 8 * g) * 2);
              asm volatile("" ::: "memory");
#pragma unroll
              for (int ct = 0; ct < 4; ++ct) o[ct] = MFMA16(af[ct], vh, o[ct]); }
#pragma unroll
            for (int ib = 0; ib < 2; ++ib) {
                s16x4 kt[4][4]; f32x4 dd[4];
#pragma unroll
                for (int ii = 0; ii < 4; ++ii) {
                    const int dk0 = (half * 8 + ib * 4 + ii) * 16;
                    const LAS unsigned char* ka = lds + KI + (8 * g + (i16 >> 2)) * QS + (dk0 + 4 * (i16 & 3)) * 2;
                    kt[ii][0] = tr_read(ka); kt[ii][1] = tr_read(ka + 4 * QS); kt[ii][2] = tr_read(ka + 32 * QS); kt[ii][3] = tr_read(ka + 36 * QS);
                    dd[ii] = *(const LAS f32x4*)(lds + DC + (dk0 + 4 * g) * 4);
                }
                asm volatile("" ::: "memory");
#pragma unroll
                for (int ii = 0; ii < 4; ++ii) {
                    const int i = ib * 4 + ii;
                    S[i] = MFMA16(cat8(kt[ii][0], kt[ii][1]), vf0, S[i]); S[i] = MFMA16(cat8(kt[ii][2], kt[ii][3]), vf1, S[i]);
                    S[i] = S[i] * dd[ii];
                }
            }
            if (half == 1) {
#pragma unroll
                for (int ct = 0; ct < 4; ++ct)
#pragma unroll
                    for (int j = 0; j < 4; ++j) *(LAS float*)(lds + XO + (ct * 16 + 4 * g + j) * XS + (dvt * 16 + i16) * 4) = o[ct][j];
            }
            LBAR();
            if (half == 0) {
#pragma unroll
                for (int ct = 0; ct < 4; ++ct)
#pragma unroll
                    for (int j = 0; j < 4; ++j) ofin[ct][j] = o[ct][j] + *(const LAS float*)(lds + XO + (ct * 16 + 4 * g + j) * XS + (dvt * 16 + i16) * 4);
            }
        }
        if (half == 0) { SCAN_FLUSH(31); }
        __syncthreads();
    }
#undef SCAN_FLUSH
}

__device__ __forceinline__ void gla_finalize(bf16* og, const bf16* proj, const float* hssq, const float* gout, int gtid, int nthr) {
    asm volatile("" : "+v"(gtid));
#define FIN_LOAD(IDX, ov, rv, rs, g0, g1) const int tok##IDX = (IDX) >> 8, c##IDX = ((IDX) & 255) * 8; \
        const v4u ov = *(const v4u*)(og + (size_t)tok##IDX * DM + c##IDX); const v4u rv = *(const v4u*)(proj + (size_t)tok##IDX * NPROJ + 4096 + c##IDX); \
        float hs##IDX = 0.f; { const f32x4* hp_ = (const f32x4*)(hssq + ((size_t)tok##IDX * 4 + (c##IDX >> 9)) * 32); \
          _Pragma("unroll") for (int q_ = 0; q_ < 8; ++q_) { const f32x4 t_ = hp_[q_]; hs##IDX += (t_[0] + t_[1]) + (t_[2] + t_[3]); } } \
        const float rs = __builtin_amdgcn_rsqf(hs##IDX * (1.0f / 512.0f) + EPS); \
        const f32x4 g0 = *(const f32x4*)(gout + c##IDX), g1 = *(const f32x4*)(gout + c##IDX + 4);
#define FIN_STORE(IDX, ov, rv, rs, g0, g1) { \
        float ovf[8] = {bflo(ov.x), bfhi(ov.x), bflo(ov.y), bfhi(ov.y), bflo(ov.z), bfhi(ov.z), bflo(ov.w), bfhi(ov.w)}; \
        float rvf[8] = {bflo(rv.x), bfhi(rv.x), bflo(rv.y), bfhi(rv.y), bflo(rv.z), bfhi(rv.z), bflo(rv.w), bfhi(rv.w)}; \
        float gg[8] = {g0[0], g0[1], g0[2], g0[3], g1[0], g1[1], g1[2], g1[3]}; float res[8]; \
        _Pragma("unroll") for (int e = 0; e < 8; ++e) { const float r = rvf[e]; res[e] = ovf[e] * rs * gg[e] * (r / (1.f + __expf(-r))); } \
        v4u w; w.x = pk2(res[0], res[1]); w.y = pk2(res[2], res[3]); w.z = pk2(res[4], res[5]); w.w = pk2(res[6], res[7]); \
        *(v4u*)(og + (size_t)tok##IDX * DM + c##IDX) = w; }
    for (int idx = gtid; idx < M_TOK * 256; idx += 4 * nthr) {
        const int idxa = idx, idxb = idx + nthr, idxc = idx + 2 * nthr, idxd = idx + 3 * nthr;
        FIN_LOAD(idxa, ova, rva, rsa, g0a, g1a)
        FIN_LOAD(idxb, ovb, rvb, rsb, g0b, g1b)
        FIN_LOAD(idxc, ovc, rvc, rsc, g0c, g1c)
        FIN_LOAD(idxd, ovd, rvd, rsd, g0d, g1d)
        asm volatile("" ::: "memory");
        FIN_STORE(idxa, ova, rva, rsa, g0a, g1a)
        FIN_STORE(idxb, ovb, rvb, rsb, g0b, g1b)
        FIN_STORE(idxc, ovc, rvc, rsc, g0c, g1c)
        FIN_STORE(idxd, ovd, rvd, rsd, g0d, g1d)
    }
#undef FIN_LOAD
#undef FIN_STORE
}

__device__ __forceinline__ void attn_phase(LAS unsigned char* lds, const bf16* qkv, const float* gq, const float* gk, const float* relb, bf16* ao, int tid, int lane, int w) {
    asm volatile("" : "+v"(tid), "+v"(lane)); asm volatile("" : "+s"(w));
    constexpr int KS = 272, VS = 288, KBUF = 64 * KS, VBUF = 64 * VS, VB0 = 2 * KBUF, BT = VB0 + 2 * VBUF;
    const int g = lane >> 4, i16 = lane & 15;
    const int srow = tid >> 4, sch = tid & 15;
    v4u qr[4], rk0, rk1, rv0, rv1;
#define ATT_QPTR(UNIT) (qkv + (size_t)((((UNIT) & 127) >> 4) * 2048 + (2 * ((UNIT) >> 7) + (w >> 2)) * 64 + (w & 3) * 16 + i16) * NPROJ + ((UNIT) & 15) * 128 + g * 8)
#define ATT_KBASE(UNIT) (qkv + (size_t)((((UNIT) & 127) >> 4) * 2048 + srow) * NPROJ + 2048 + ((UNIT) & 15) * 128 + sch * 8)
#define ATT_KCLO(UNIT) ((2 * ((UNIT) >> 7) - 8 > 0) ? (2 * ((UNIT) >> 7) - 8) : 0)
#define ATT_LOADP(KB, kc) do { const bf16* p_ = (KB) + (size_t)(kc) * 64 * NPROJ; rk0 = *(const v4u*)p_; rk1 = *(const v4u*)(p_ + (size_t)32 * NPROJ); \
                          rv0 = *(const v4u*)(p_ + 2048); rv1 = *(const v4u*)(p_ + (size_t)32 * NPROJ + 2048); } while (0)
    if ((int)blockIdx.x < 2048) { const int un_ = blockIdx.x; const bf16* qp_ = ATT_QPTR(un_);
#pragma unroll
        for (int ks = 0; ks < 4; ++ks) qr[ks] = *(const v4u*)(qp_ + ks * 32);
        ATT_LOADP(ATT_KBASE(un_), ATT_KCLO(un_)); }
    int hprev = -1;
    f32x4 gqa[4], gqb[4];
#pragma unroll
    for (int ks = 0; ks < 4; ++ks) {
        gqa[ks] = *(const f32x4*)(gq + ks * 32 + g * 8) * *(const f32x4*)(gk + ks * 32 + g * 8) * (0.08838834764831845f * LOG2E);
        gqb[ks] = *(const f32x4*)(gq + ks * 32 + g * 8 + 4) * *(const f32x4*)(gk + ks * 32 + g * 8 + 4) * (0.08838834764831845f * LOG2E); }
    for (int unit = blockIdx.x; unit < 2048; unit += gridDim.x) {
        const int nunit = unit + (int)gridDim.x;
        const int u = unit >> 7, bh = unit & 127, b = bh >> 4, h = bh & 15;
        const int n0 = 2 * u, nq = n0 + (w >> 2);
        if (h != hprev) { if (tid < 320) *(LAS float*)(lds + BT + tid * 4) = relb[h * 320 + tid] * LOG2E; hprev = h; }
        bf16x8 qf[4];
        {
            float ss = 0.f;
#pragma unroll
            for (int ks = 0; ks < 4; ++ks) {
                const float a0 = bflo(qr[ks].x), a1 = bfhi(qr[ks].x), a2 = bflo(qr[ks].y), a3 = bfhi(qr[ks].y), a4 = bflo(qr[ks].z), a5 = bfhi(qr[ks].z), a6 = bflo(qr[ks].w), a7 = bfhi(qr[ks].w);
                ss += (a0 * a0 + a1 * a1) + (a2 * a2 + a3 * a3) + (a4 * a4 + a5 * a5) + (a6 * a6 + a7 * a7); }
            ss = xrow_sum(ss);
            const float rs = __builtin_amdgcn_rsqf(ss * (1.0f / 128.0f) + EPS);
#pragma unroll
            for (int ks = 0; ks < 4; ++ks) {
                const f32x4 ga = gqa[ks], gb = gqb[ks];
                v4u o; o.x = pk2(bflo(qr[ks].x) * rs * ga[0], bfhi(qr[ks].x) * rs * ga[1]); o.y = pk2(bflo(qr[ks].y) * rs * ga[2], bfhi(qr[ks].y) * rs * ga[3]);
                o.z = pk2(bflo(qr[ks].z) * rs * gb[0], bfhi(qr[ks].z) * rs * gb[1]); o.w = pk2(bflo(qr[ks].w) * rs * gb[2], bfhi(qr[ks].w) * rs * gb[3]);
                qf[ks] = __builtin_bit_cast(bf16x8, o);
            }
        }
        const int kc_lo = (n0 - 8 > 0) ? (n0 - 8) : 0, ntiles = n0 + 2 - kc_lo;
        const bf16* kbase = qkv + (size_t)(b * 2048 + srow) * NPROJ + 2048 + h * 128 + sch * 8;
#define ATT_LOAD(kc) do { const bf16* p_ = kbase + (size_t)(kc) * 64 * NPROJ; rk0 = *(const v4u*)p_; rk1 = *(const v4u*)(p_ + (size_t)32 * NPROJ); \
                          rv0 = *(const v4u*)(p_ + 2048); rv1 = *(const v4u*)(p_ + (size_t)32 * NPROJ + 2048); } while (0)
#define ATT_KNORM(r, dstrow, buf) do { \
            const float a0 = bflo(r.x), a1 = bfhi(r.x), a2 = bflo(r.y), a3 = bfhi(r.y), a4 = bflo(r.z), a5 = bfhi(r.z), a6 = bflo(r.w), a7 = bfhi(r.w); \
            float s_ = (a0 * a0 + a1 * a1) + (a2 * a2 + a3 * a3) + (a4 * a4 + a5 * a5) + (a6 * a6 + a7 * a7); \
            s_ = dpp_sum16(s_); \
            const float rs_ = __builtin_amdgcn_rsqf(s_ * (1.0f / 128.0f) + EPS); v4u o_; \
            o_.x = pk2(a0 * rs_, a1 * rs_); o_.y = pk2(a2 * rs_, a3 * rs_); o_.z = pk2(a4 * rs_, a5 * rs_); o_.w = pk2(a6 * rs_, a7 * rs_); \
            *(LAS v4u*)(lds + (buf) * KBUF + (dstrow) * KS + sch * 16) = o_; } while (0)
#define ATT_WRITE(buf) do { ATT_KNORM(rk0, srow, buf); ATT_KNORM(rk1, srow + 32, buf); \
            *(LAS v4u*)(lds + VB0 + (buf) * VBUF + srow * VS + sch * 16) = rv0; *(LAS v4u*)(lds + VB0 + (buf) * VBUF + (srow + 32) * VS + sch * 16) = rv1; } while (0)
        ATT_WRITE(0);
        ATT_LOAD(kc_lo + 1);
        LBAR();
        f32x4 OT[8];
#pragma unroll
        for (int dt = 0; dt < 8; ++dt) OT[dt] = (f32x4){0.f, 0.f, 0.f, 0.f};
        float mrun = -1e30f, lrun = 0.f;
        const int qi = (w & 3) * 16 + i16;
        for (int t = 0; t < ntiles; ++t) {
            const int kc = kc_lo + t, buf = t & 1;
            if (t + 1 < ntiles) ATT_WRITE(buf ^ 1);
            if (t + 2 < ntiles) ATT_LOAD(kc + 2);
            if (t == ntiles - 1 && nunit < 2048) { const bf16* qp_ = ATT_QPTR(nunit);
#pragma unroll
                for (int ks = 0; ks < 4; ++ks) qr[ks] = *(const v4u*)(qp_ + ks * 32);
                ATT_LOADP(ATT_KBASE(nunit), ATT_KCLO(nunit)); }
            if (kc >= nq - 8 && kc <= nq) {
                const LAS unsigned char* Kb = lds + buf * KBUF;
                const LAS unsigned char* Vb = lds + VB0 + buf * VBUF;
                f32x4 s[4];
                {
                    bf16x8 kf[4][4];
#pragma unroll
                    for (int kt = 0; kt < 4; ++kt)
#pragma unroll
                        for (int ks = 0; ks < 4; ++ks) kf[kt][ks] = *(const LAS bf16x8*)(Kb + (kt * 16 + i16) * KS + ks * 64 + g * 16);
                    asm volatile("" ::: "memory");
#pragma unroll
                    for (int kt = 0; kt < 4; ++kt) s[kt] = (f32x4){0.f, 0.f, 0.f, 0.f};
#pragma unroll
                    for (int ks = 0; ks < 4; ++ks)
#pragma unroll
                        for (int kt = 0; kt < 4; ++kt) s[kt] = MFMA16(kf[kt][ks], qf[ks], s[kt]);
                }
                const int dchunk = nq - kc;
                if (dchunk >= 5) {
                    const float bc = *(const LAS float*)(lds + BT + 319 * 4);
#pragma unroll
                    for (int kt = 0; kt < 4; ++kt) s[kt] = s[kt] + bc;
                } else if (dchunk <= 3) {
                    const LAS float* bp = (const LAS float*)(lds + BT) + (dchunk * 64 + qi - 4 * g + 12);
#pragma unroll
                    for (int kt = 0; kt < 4; ++kt)
#pragma unroll
                        for (int j = 0; j < 4; ++j) s[kt][j] += bp[51 - kt * 16 - j];
                } else {
                    const int dbase = dchunk * 64 + qi - 4 * g + 63;
#pragma unroll
                    for (int kt = 0; kt < 4; ++kt)
#pragma unroll
                        for (int j = 0; j < 4; ++j) { int idx = dbase - kt * 16 - j; idx = idx < 0 ? 0 : (idx > 319 ? 319 : idx); s[kt][j] += *(const LAS float*)(lds + BT + idx * 4); }
                }
                float mx = fmaxf(fmaxf(s[0][0], s[0][1]), fmaxf(s[0][2], s[0][3]));
#pragma unroll
                for (int kt = 1; kt < 4; ++kt) mx = fmaxf(mx, fmaxf(fmaxf(s[kt][0], s[kt][1]), fmaxf(s[kt][2], s[kt][3])));
                mx = xrow_max(mx);
                const float mnew = fmaxf(mrun, mx), alpha = __builtin_amdgcn_exp2f(mrun - mnew);
                mrun = mnew;
                float rsum = 0.f;
#pragma unroll
                for (int kt = 0; kt < 4; ++kt)
#pragma unroll
                    for (int j = 0; j < 4; ++j) { const float p = __builtin_amdgcn_exp2f(s[kt][j] - mnew); s[kt][j] = p; rsum += p; }
                rsum = xrow_sum(rsum);
                lrun = lrun * alpha + rsum;
#pragma unroll
                for (int dt = 0; dt < 8; ++dt) OT[dt] = OT[dt] * alpha;
                const bf16x8 pf0 = pack8(s[0], s[1]), pf1 = pack8(s[2], s[3]);
                const LAS unsigned char* va = Vb + (4 * g + (i16 >> 2)) * VS + (4 * (i16 & 3)) * 2;
#pragma unroll
                for (int db = 0; db < 2; ++db) {
                    s16x4 vt[4][4];
#pragma unroll
                    for (int dd = 0; dd < 4; ++dd) { const int dt = db * 4 + dd;
                        vt[dd][0] = tr_read(va + dt * 32); vt[dd][1] = tr_read(va + 16 * VS + dt * 32); vt[dd][2] = tr_read(va + 32 * VS + dt * 32); vt[dd][3] = tr_read(va + 48 * VS + dt * 32); }
                    asm volatile("" ::: "memory");
#pragma unroll
                    for (int dd = 0; dd < 4; ++dd) { const int dt = db * 4 + dd;
                        OT[dt] = MFMA16(cat8(vt[dd][0], vt[dd][1]), pf0, OT[dt]); OT[dt] = MFMA16(cat8(vt[dd][2], vt[dd][3]), pf1, OT[dt]); }
                }
            }
            LBAR();
        }
        {
            const float inv = 1.0f / lrun;
            bf16* op = ao + (size_t)(b * 2048 + nq * 64 + qi) * DM + h * 128 + 4 * g;
#pragma unroll
            for (int dt = 0; dt < 8; ++dt) { v2u o; o.x = pk2(OT[dt][0] * inv, OT[dt][1] * inv); o.y = pk2(OT[dt][2] * inv, OT[dt][3] * inv); *(v2u*)(op + dt * 16) = o; }
        }
    }
#undef ATT_LOAD
#undef ATT_LOADP
#undef ATT_QPTR
#undef ATT_KBASE
#undef ATT_KCLO
#undef ATT_KNORM
#undef ATT_WRITE
}

#define RLX_AGENT __ATOMIC_RELAXED, __HIP_MEMORY_SCOPE_AGENT
#define XB_TMO      128
#define XB_XCNT(j)  (256  + 64 * (j))
#define XB_XSUB(j)  (1280 + 64 * (j))
#define XB_XGEN(j)  (2304 + 64 * (j))
#define XB_TOP      3328
#define XB_TOPGEN   3392
#define XCD_BAR_WORDS 3456
#define XB_SPIN_CAP (1u << 18)

__device__ __forceinline__ unsigned xb_ld(unsigned* p)              { return __hip_atomic_load(p, __ATOMIC_RELAXED, __HIP_MEMORY_SCOPE_AGENT); }
__device__ __forceinline__ unsigned xb_add(unsigned* p, unsigned v) { return __hip_atomic_fetch_add(p, v, __ATOMIC_RELAXED, __HIP_MEMORY_SCOPE_AGENT); }
__device__ __forceinline__ unsigned xb_xcc_id() { return (unsigned)__builtin_amdgcn_s_getreg((3 << 11) | 20) & 0xFu; }
#define XB_SPIN(cond, bar) do { unsigned _sp = 0; while (cond) { __builtin_amdgcn_s_sleep(1); \
    if ((++_sp & 255u) == 0u) { if (xb_ld(&(bar)[XB_TMO])) break; if (_sp > XB_SPIN_CAP) { atomicAdd(&(bar)[XB_TMO], 1u); break; } } } } while (0)

struct XcdBarrier {
    unsigned* bar; unsigned x;
    volatile LAS unsigned* st;
};

__device__ __forceinline__ XcdBarrier xcd_barrier_post(unsigned* bar, volatile LAS unsigned* st) {
    XcdBarrier b; b.bar = bar; b.x = xb_xcc_id(); b.st = st;
    if (threadIdx.x == 0) (void)xb_add(&bar[XB_XCNT(b.x)], 1u);
    return b;
}
__device__ __forceinline__ void xcd_barrier_complete(unsigned* bar, unsigned x, unsigned& nloc, unsigned& nx) {
    const unsigned G = gridDim.x * gridDim.y * gridDim.z;
    unsigned sum, cnt, mine, sp = 0u;
    for (;;) {
        sum = 0u; cnt = 0u; mine = 0u;
#pragma unroll
        for (unsigned j = 0; j < 16; ++j) { const unsigned c = xb_ld(&bar[XB_XCNT(j)]); sum += c; cnt += (c > 0u) ? 1u : 0u; mine = (j == x) ? c : mine; }
        if (sum == G) break;
        __builtin_amdgcn_s_sleep(1);
        if ((++sp & 255u) == 0u) { if (xb_ld(&bar[XB_TMO])) break; if (sp > XB_SPIN_CAP) { atomicAdd(&bar[XB_TMO], 1u); break; } }
    }
    nloc = mine > 0u ? mine : 1u; nx = cnt > 0u ? cnt : 1u;
}

__device__ __forceinline__ void xcd_barrier(const XcdBarrier& b) {
    asm volatile("s_waitcnt vmcnt(0)" ::: "memory");
    __syncthreads();
    if (threadIdx.x == 0) {
        unsigned* bar = b.bar;
        __builtin_amdgcn_s_waitcnt(0);
        unsigned nloc = b.st[0], nx = b.st[1];
        if (nloc == 0u) { xcd_barrier_complete(bar, b.x, nloc, nx); b.st[0] = nloc; b.st[1] = nx; }
        const unsigned old = xb_add(&bar[XB_XSUB(b.x)], 1u);
        const unsigned gen = old / nloc;
        if (old + 1u == (gen + 1u) * nloc) {
            __builtin_amdgcn_fence(__ATOMIC_RELEASE, "agent");
            asm volatile("s_waitcnt vmcnt(0)" ::: "memory");
            const unsigned og = xb_add(&bar[XB_TOP], 1u);
            const unsigned tg = og / nx;
            if (og + 1u == (tg + 1u) * nx) xb_add(&bar[XB_TOPGEN], 1u);
            else XB_SPIN(xb_ld(&bar[XB_TOPGEN]) == tg, bar);
            __builtin_amdgcn_fence(__ATOMIC_ACQUIRE, "agent");
            xb_add(&bar[XB_XGEN(b.x)], 1u);
            asm volatile("s_waitcnt vmcnt(0)" ::: "memory");
        } else {
            XB_SPIN(xb_ld(&bar[XB_XGEN(b.x)]) == gen, bar);
            __builtin_amdgcn_fence(__ATOMIC_ACQUIRE, "agent");
            asm volatile("s_waitcnt vmcnt(0)" ::: "memory");
        }
    }
    __syncthreads();
}

struct Args { const float* in[15]; float* out; unsigned char* ws; };
typedef const __attribute__((address_space(4))) unsigned char* kptr_t;
__device__ __forceinline__ kptr_t kfresh(kptr_t p) { asm volatile("" : "+s"(p)); return p; }
#define KIN(i) (*(const float* const __attribute__((address_space(4)))*)(kfresh(kargp) + 8 * (i)))
#define KOUT() ((float*)*(const float* const __attribute__((address_space(4)))*)(kfresh(kargp) + 120))
#define KWS() ((unsigned char*)*(const float* const __attribute__((address_space(4)))*)(kfresh(kargp) + 128))
__global__ void __launch_bounds__(512, 2) mega_fwd(Args args) {
    extern __shared__ __attribute__((aligned(16))) unsigned char lds_raw[];
    cg::grid_group grid = cg::this_grid();
    LAS unsigned char* lds = (LAS unsigned char*)lds_raw;
    const kptr_t kargp = (kptr_t)__builtin_amdgcn_kernarg_segment_ptr();
#define PHASE_IDS() int tid = threadIdx.x; asm volatile("" : "+v"(tid)); const int lane = tid & 63, wave = __builtin_amdgcn_readfirstlane(tid >> 6); \
    const int gw = blockIdx.x * 8 + wave, gtid = blockIdx.x * 512 + tid; (void)lane; (void)wave; (void)gw; (void)gtid;
    if (threadIdx.x < 4) ((volatile LAS unsigned*)(lds + 140000))[threadIdx.x] = 0u;
    __syncthreads();
    const XcdBarrier xbar = xcd_barrier_post((unsigned*)(KWS() + WS_BAR), (volatile LAS unsigned*)(lds + 140000));
#define GSYNC() xcd_barrier(xbar)
    const int G = gridDim.x, NGW = G * 8, nthr = G * 512;

#pragma unroll
    for (int L = 0; L < 2; ++L) {
        if (L == 0) {
            PHASE_IDS()
            unsigned char* ws = KWS();
            const float* Win = KIN(3); const float* gm = KIN(1); const float* x = KIN(0);
#ifdef REP_CONV
            int reps = 2; asm volatile("" : "+s"(reps));
            for (int rep = 0; rep < reps; ++rep)
#endif
            convert_weights(Win, GLA_LD, gm, KIN(7), KIN(13), KIN(2), KIN(14), ws, lds, tid, G);
            bf16* WzT = (bf16*)(ws + WS_WZT); float* ssq = (float*)(ws + WS_SSQ); float* hssq = (float*)(ws + WS_HSSQ); bf16* xb = (bf16*)(ws + WS_XB);
            for (int i = gtid; i < 16 * 2048; i += nthr) { const int j = i >> 11, k = i & 2047; WzT[j * 2048 + k] = f2bf(Win[(size_t)k * GLA_LD + 6144 + j] * gm[k]); }
            for (int i = gtid; i < 3 * 16384; i += nthr) ssq[16384 + i] = 0.f;
            for (int i = gtid; i < 4 * 16384; i += nthr) hssq[i] = 0.f;
            for (int m = gw; m < M_TOK; m += 2 * NGW) {
                const int m2 = m + NGW;
                const f32x4* xr = (const f32x4*)(x + (size_t)m * DM) + lane; const f32x4* xr2 = (const f32x4*)(x + (size_t)m2 * DM) + lane;
                f32x4 v[8], v2[8]; float s = 0.f, s2 = 0.f;
#pragma unroll
                for (int j = 0; j < 8; ++j) v[j] = __builtin_nontemporal_load(xr + 64 * j);
#pragma unroll
                for (int j = 0; j < 8; ++j) v2[j] = __builtin_nontemporal_load(xr2 + 64 * j);
#pragma unroll
                for (int j = 0; j < 8; ++j) { s += (v[j].x * v[j].x + v[j].y * v[j].y) + (v[j].z * v[j].z + v[j].w * v[j].w); s2 += (v2[j].x * v2[j].x + v2[j].y * v2[j].y) + (v2[j].z * v2[j].z + v2[j].w * v2[j].w); }
                s = wave_sum(s); s2 = wave_sum(s2); if (lane == 0) { ssq[m] = s; ssq[m2] = s2; }
                unsigned long long* o8 = (unsigned long long*)(xb + (size_t)m * DM) + lane; unsigned long long* o82 = (unsigned long long*)(xb + (size_t)m2 * DM) + lane;
#pragma unroll
                for (int j = 0; j < 8; ++j) { o8[64 * j] = (unsigned long long)pk2(v[j].x, v[j].y) | ((unsigned long long)pk2(v[j].z, v[j].w) << 32);
                                              o82[64 * j] = (unsigned long long)pk2(v2[j].x, v2[j].y) | ((unsigned long long)pk2(v2[j].z, v2[j].w) << 32); }
            }
            __syncthreads();
            for (int u = blockIdx.x; u < 256; u += G) {
                const int b = u >> 5, cgp = u & 31;
                LAS float* xs = (LAS float*)lds; LAS float* part = (LAS float*)(lds + 8192); LAS float* red = (LAS float*)(lds + 12288);
                const float* xr = x + (size_t)b * 2048 * DM;
                float s = 0.f;
                for (int i = tid; i < 2048; i += 512) { const float v = xr[i]; s += v * v; xs[i] = v * gm[i]; }
                s = wave_sum(s); if (lane == 0) red[wave] = s;
                __syncthreads();
                float tot = 0.f;
#pragma unroll
                for (int ww = 0; ww < 8; ++ww) tot += red[ww];
                const float rstd = __builtin_amdgcn_rsqf(tot * (1.0f / 2048.0f) + EPS);
                const int col = cgp * 64 + lane;
                float acc = 0.f;
#pragma unroll 32
                for (int k = wave * 256; k < wave * 256 + 256; ++k) acc += xs[k] * Win[(size_t)k * GLA_LD + col];
                part[wave * 64 + lane] = acc;
                __syncthreads();
                if (wave == 0) { float t2 = 0.f;
#pragma unroll
                    for (int ww = 0; ww < 8; ++ww) t2 += part[ww * 64 + lane];
                    ((float*)(ws + WS_QK0))[b * 2048 + col] = t2 * rstd; }
                __syncthreads();
            }
        } else {
            PHASE_IDS()
            convert_weights(KIN(8), NPROJ, KIN(1) + DM, KIN(12), KIN(13) + (size_t)DM * FF, KIN(2) + DM, KIN(14) + (size_t)FF * DM, KWS(), lds, tid, G);
        }
        __syncthreads();
        if (G > 0x3fffffff) grid.sync();
        GSYNC();
#ifdef REP_SYNC
        for (int rep = 0; rep < 5; ++rep) GSYNC();
#endif
        {
            unsigned char* ws = KWS();
            pg8::Gemm gm{(const bf16*)(ws + WS_XB), (const bf16*)(ws + WS_WIN), M_TOK, NPROJ, DM}; pg8::StaticOrder S; S.init(M_TOK, NPROJ, G, (int)blockIdx.x);
            pg8::EpiBf16S<0> E{(bf16*)(ws + WS_PROJ), NPROJ, (const float*)(ws + WS_SSQ) + (L == 0 ? 0 : 2 * 16384)};
#ifdef REP_INPROJ
            int reps = 2; asm volatile("" : "+s"(reps));
            for (int rep = 0; rep < reps; ++rep)
#endif
            pg8::gemm_phase<pg8::EpiBf16S<0>, pg8::StaticOrder, true, true>(lds, gm, S, E);
        }
        GSYNC();
        if (L == 0) {
            { PHASE_IDS() unsigned char* ws = KWS();
              gla_prep(lds, (const bf16*)(ws + WS_XB), (const bf16*)(ws + WS_WZT), (const float*)(ws + WS_SSQ), KIN(4), KIN(5), (bf16*)(ws + WS_PROJ), (float*)(ws + WS_DEC), tid, lane, wave);
            }
            GSYNC();
            { PHASE_IDS() unsigned char* ws = KWS();
#ifdef REP_SCAN
              int reps = 2; asm volatile("" : "+s"(reps));
              for (int rep = 0; rep < reps; ++rep)
              gla_scan(lds, (const bf16*)(ws + WS_PROJ), (const float*)(ws + WS_DEC), (const float*)(ws + WS_QK0), (bf16*)(ws + WS_OG), (float*)(ws + (rep == 0 ? WS_HPART : WS_END)), tid, lane, wave);
#else
              gla_scan(lds, (const bf16*)(ws + WS_PROJ), (const float*)(ws + WS_DEC), (const float*)(ws + WS_QK0), (bf16*)(ws + WS_OG), (float*)(ws + WS_HPART), tid, lane, wave);
#endif
            }
            GSYNC();
            { PHASE_IDS() unsigned char* ws = KWS();
              gla_finalize((bf16*)(ws + WS_OG), (const bf16*)(ws + WS_PROJ), (const float*)(ws + WS_HPART), KIN(6), gtid, nthr);
            }
        } else {
            PHASE_IDS()
            unsigned char* ws = KWS();
#ifdef REP_ATTN
            int reps = 2; asm volatile("" : "+s"(reps));
            for (int rep = 0; rep < reps; ++rep)
#endif
            attn_phase(lds, (const bf16*)(ws + WS_PROJ), KIN(9), KIN(10), KIN(11), (bf16*)(ws + WS_OG), tid, lane, wave);
        }
        __syncthreads();
        GSYNC();
        {
            unsigned char* ws = KWS(); float* out = KOUT();
            pg8::Gemm gm{(const bf16*)(ws + WS_OG), (const bf16*)(ws + WS_WO), M_TOK, DM, DM}; pg8::StaticOrder S; S.init(M_TOK, DM, G, (int)blockIdx.x);
            pg8::EpiRes E{(bf16*)(ws + WS_XB), out, (float*)(ws + WS_SSQ) + (L == 0 ? 1 : 3) * 16384, DM, 0};
            pg8::gemm_phase<pg8::EpiRes, pg8::StaticOrder, false, true>(lds, gm, S, E);
        }
        GSYNC();
        {
            unsigned char* ws = KWS();
            pg8::Gemm gm{(const bf16*)(ws + WS_XB), (const bf16*)(ws + WS_WUP), M_TOK, FF, DM}; pg8::StaticOrder S; S.init(M_TOK, FF, G, (int)blockIdx.x);
            pg8::EpiBf16S<1> E{(bf16*)(ws + WS_U), FF, (const float*)(ws + WS_SSQ) + (L == 0 ? 1 : 3) * 16384};
#ifdef REP_UP
            int reps = 2; asm volatile("" : "+s"(reps));
            for (int rep = 0; rep < reps; ++rep)
#endif
            pg8::gemm_phase<pg8::EpiBf16S<1>, pg8::StaticOrder, true, true>(lds, gm, S, E);
        }
        GSYNC();
        {
            unsigned char* ws = KWS(); float* out = KOUT();
            pg8::Gemm gm{(const bf16*)(ws + WS_U), (const bf16*)(ws + WS_WDN), M_TOK, DM, FF, 1}; pg8::StaticOrder S; S.init(M_TOK, DM, G, (int)blockIdx.x, 4);
            pg8::EpiRes E{(bf16*)(ws + WS_XB), out, (float*)(ws + WS_SSQ) + 2 * 16384, DM, L == 0 ? 0 : 1};
            pg8::gemm_phase<pg8::EpiRes, pg8::StaticOrder, false, true>(lds, gm, S, E);
        }
        if (L == 0) GSYNC();
    }
}

extern "C" void kernel_launch(void* const* d_in, const int* in_sizes, int n_in, void* d_out, int out_size, void* d_ws, size_t ws_size, hipStream_t stream) {
    static int grid = 0;
    if (grid == 0) {
        if (n_in != 15 || out_size != M_TOK * DM || ws_size < WS_END) { fprintf(stderr, "kernel_launch: unexpected shapes (n_in %d, out %d, ws %zu)\n", n_in, out_size, ws_size); grid = -1; return; }
        int dev = 0, cus = 0, per_cu = 0;
        (void)hipGetDevice(&dev);
        (void)hipDeviceGetAttribute(&cus, hipDeviceAttributeMultiprocessorCount, dev);
        (void)hipFuncSetAttribute((const void*)mega_fwd, hipFuncAttributeMaxDynamicSharedMemorySize, LDS_BYTES);
        (void)hipOccupancyMaxActiveBlocksPerMultiprocessor(&per_cu, (const void*)mega_fwd, 512, LDS_BYTES);
        if (per_cu < 1) per_cu = 1;
        if (cus < 1) cus = 256;
        (void)hipGetLastError();
        grid = cus * per_cu;
    }
    if (grid < 0) return;
    if (hipMemsetAsync((char*)d_ws + WS_BAR, 0, 16384, stream) != hipSuccess) { fprintf(stderr, "kernel_launch: memset failed\n"); return; }
    Args a{};
    for (int i = 0; i < 15; ++i) a.in[i] = (const float*)d_in[i];
    a.out = (float*)d_out; a.ws = (unsigned char*)d_ws;
    void* kargs[] = {&a};
    hipError_t e = hipLaunchCooperativeKernel((const void*)mega_fwd, dim3(grid), dim3(512), kargs, LDS_BYTES, stream);
    if (e != hipSuccess) fprintf(stderr, "cooperative launch failed: %s (grid %d)\n", hipGetErrorString(e), grid);
}
```

```cpp
#include <hip/hip_runtime.h>
#include <hip/hip_cooperative_groups.h>
#include <cstdio>
#include <cstdint>
namespace cg = cooperative_groups;

namespace pg8 {
#define PG8_LAS __attribute__((address_space(3)))
typedef unsigned short bf16_t;
typedef short bf16x8 __attribute__((ext_vector_type(8)));
typedef float f32x4 __attribute__((ext_vector_type(4)));
typedef unsigned u32x4 __attribute__((ext_vector_type(4)));
constexpr int BM = 256, BK = 64, HALF = 128, HTB = HALF * BK * 2  , STAGE_BYTES = 8 * HTB, NXCD = 8, WGM = 8;

__host__ __device__ __forceinline__ int lds_byte(int r, int c) { const int st = (r >> 4) * 2 + (c >> 5), rr = r & 15, cc = c & 31, ob = rr * 64 + cc * 2; return st * 1024 + (ob ^ (((ob >> 9) & 1) << 5)); }
__host__ __device__ __forceinline__ void stage_rc(int b, int& R, int& C) { const int st = b / 1024, sb = b % 1024, swz = sb ^ (((sb >> 9) & 1) << 5); R = (st >> 1) * 16 + swz / 64; C = (st & 1) * 32 + (swz % 64) / 2; }
__host__ __device__ __forceinline__ int perm32(int rho) { const int n = rho >> 4, i = rho & 15; return 8 * (i >> 2) + 4 * n + (i & 3); }

struct Unit { int pm, pn; };
struct Gemm { const bf16_t* A; const bf16_t* Bt; int M, N, K; };

struct StaticOrder {
    int nM, nN, nwg, G, c, wgm;
    __host__ __device__ void init(int M, int N, int G_, int c_, int wgm_ = WGM) { nM = M / BM; nN = N / BM; nwg = nM * nN; G = G_; c = c_; wgm = wgm_; }
    __host__ __device__ bool next(int i, Unit& u) const {
        const long L = (long)i * G + c; if (L >= nwg) return false;
        int wgid = (int)L; { const int q = nwg / NXCD, r = nwg % NXCD, xcd = wgid % NXCD, off = wgid / NXCD; wgid = (xcd < r ? xcd * (q + 1) : r * (q + 1) + (xcd - r) * q) + off; }
        const int nig = wgm * nN, gid = wgid / nig, fm = gid * wgm, gsz = (nM - fm) < wgm ? (nM - fm) : wgm;
        u.pm = fm + ((wgid % nig) % gsz); u.pn = (wgid % nig) / gsz; return true;
    }
    __device__ __forceinline__ void a_ready(const Unit&) const {}
    __device__ __forceinline__ void done(const Unit&) const {}
};

__device__ __forceinline__ unsigned cvt_pk_bf16(float lo, float hi) { unsigned r; asm volatile("v_cvt_pk_bf16_f32 %0, %1, %2" : "=v"(r) : "v"(lo), "v"(hi)); return r; }
typedef float f32x2 __attribute__((ext_vector_type(2)));
typedef unsigned u32x2 __attribute__((ext_vector_type(2)));
template <int ACT> struct EpiBf16S {
    static constexpr bool PERM = true, AFTER_DRAIN = false;
    bf16_t* O; int ldc; const float* ssq;
    __device__ __forceinline__ void operator()(const f32x4 (&acc)[2][2][4][2], const Unit& u, int wr, int wc, int fr, int fq) const {
        const int row0 = u.pm * BM + wr * 64 + fr; const int col0 = u.pn * BM + wc * 32 + 8 * fq;
        float sv[2][4];
#pragma unroll
        for (int ai = 0; ai < 2; ++ai)
#pragma unroll
            for (int m = 0; m < 4; ++m) sv[ai][m] = ssq[row0 + ai * HALF + m * 16];
        asm volatile("" ::: "memory");
#pragma unroll
        for (int ai = 0; ai < 2; ++ai)
#pragma unroll
            for (int m = 0; m < 4; ++m) {
                const int row = row0 + ai * HALF + m * 16;
                const float rs = __builtin_amdgcn_rsqf(sv[ai][m] * (1.0f / 2048.0f) + 1e-6f);
                bf16_t* rowp = O + (size_t)row * ldc + col0;
#pragma unroll
                for (int bj = 0; bj < 2; ++bj) {
                    f32x4 v0 = acc[ai][bj][m][0] * rs, v1 = acc[ai][bj][m][1] * rs;
                    if (ACT == 1) {
#pragma unroll
                        for (int e = 0; e < 4; ++e) { float a = fmaxf(v0[e], 0.f); v0[e] = a * a; float b = fmaxf(v1[e], 0.f); v1[e] = b * b; }
                    }
                    u32x4 w; w.x = cvt_pk_bf16(v0[0], v0[1]); w.y = cvt_pk_bf16(v0[2], v0[3]); w.z = cvt_pk_bf16(v1[0], v1[1]); w.w = cvt_pk_bf16(v1[2], v1[3]);
                    *(u32x4*)(rowp + bj * HALF) = w;
                }
            }
    }
};
struct EpiRes {
    static constexpr bool PERM = false, AFTER_DRAIN = false;
    bf16_t* xb; float* outf; float* ssq; int ldc; int fin;
    __device__ __forceinline__ void operator()(const f32x4 (&acc)[2][2][4][2], const Unit& u, int wr, int wc, int fr, int fq) const {
        const int row0 = u.pm * BM + wr * 64 + fr; const int col0 = u.pn * BM + wc * 32 + 4 * fq;
#pragma unroll
        for (int ai = 0; ai < 2; ++ai) {
            u32x2 bv[4][2][2];
#pragma unroll
            for (int m = 0; m < 4; ++m) { const size_t off = (size_t)(row0 + ai * HALF + m * 16) * ldc + col0;
#pragma unroll
                for (int bj = 0; bj < 2; ++bj)
#pragma unroll
                    for (int n = 0; n < 2; ++n) bv[m][bj][n] = *(const u32x2*)(xb + off + bj * HALF + n * 16); }
            asm volatile("" ::: "memory");
#pragma unroll
            for (int m = 0; m < 4; ++m) {
                const int row = row0 + ai * HALF + m * 16;
                const size_t off = (size_t)row * ldc + col0;
                float s = 0.f;
#pragma unroll
                for (int bj = 0; bj < 2; ++bj)
#pragma unroll
                    for (int n = 0; n < 2; ++n) {
                        const size_t c = off + bj * HALF + n * 16;
                        const u32x2 w0 = bv[m][bj][n];
                        const f32x4 b = {__uint_as_float(w0.x << 16), __uint_as_float(w0.x & 0xffff0000u), __uint_as_float(w0.y << 16), __uint_as_float(w0.y & 0xffff0000u)};
                        const f32x4 o = b + acc[ai][bj][m][n];
                        if (fin) { *(f32x4*)(outf + c) = o; }
                        else { u32x2 w; w.x = cvt_pk_bf16(o[0], o[1]); w.y = cvt_pk_bf16(o[2], o[3]); *(u32x2*)(xb + c) = w;
                               s += (o[0] * o[0] + o[1] * o[1]) + (o[2] * o[2] + o[3] * o[3]); }
                    }
                if (!fin) { s += __shfl_xor(s, 16); s += __shfl_xor(s, 32); if (fq == 0) unsafeAtomicAdd(ssq + row, s); }
            }
            asm volatile("" ::: "memory");
        }
    }
};

template <class Epi, class Sched, bool ALIGN_EPI = false, bool SP2 = false>
__device__ __forceinline__ void gemm_phase(PG8_LAS unsigned char* lds, const Gemm g, const Sched& S, const Epi& E) {
    int tid_ = threadIdx.x; asm volatile("" : "+v"(tid_));
    const int tid = tid_, wid = __builtin_amdgcn_readfirstlane(tid >> 6), lane = tid & 63, wr = wid >> 2, wc = wid & 3, fr = lane & 15, fq = lane >> 4;
    const int K = g.K, nt = K / BK;
    unsigned voffA[2], voffB[2];
#pragma unroll
    for (int i = 0; i < 2; ++i) { int R, C; stage_rc(tid * 16 + i * 8192, R, C); const int Rb = Epi::PERM ? ((R & ~31) + perm32(R & 31)) : R;
        voffA[i] = (unsigned)(R * K + C) * 2u; voffB[i] = (unsigned)(Rb * K + C) * 2u; }
    const size_t kstep = (size_t)(BK * 2);
    const size_t hstep = (size_t)HALF * K * 2;
    const size_t tstep = 2 * hstep;
    const unsigned ldsw = (unsigned)wid * 1024u;
    const int aoff = lds_byte(wr * 64 + fr, fq * 8), boff = lds_byte(wc * 32 + fr, fq * 8);
#define PG8_SA(b, h) (((b) * 2 + (h)) * HTB)
#define PG8_SB(b, h) ((4 + (b) * 2 + (h)) * HTB)
#define PG8_STAGE(bufoff, gbase, voff) do { _Pragma("unroll") for (int _i = 0; _i < 2; ++_i) \
        __builtin_amdgcn_global_load_lds((const unsigned*)((const char*)(gbase) + (voff)[_i]), (PG8_LAS unsigned*)(lds + (bufoff) + ldsw + _i * 8192), 16, 0, 0); } while (0)
#define PG8_LDA(dst, b, h) do { _Pragma("unroll") for (int m = 0; m < 4; ++m) _Pragma("unroll") for (int k = 0; k < 2; ++k) dst[m][k] = *(const PG8_LAS bf16x8*)(lds + PG8_SA(b, h) + aoff + m * 2048 + k * 1024); } while (0)
#define PG8_LDB(dst, b, h) do { _Pragma("unroll") for (int n = 0; n < 2; ++n) _Pragma("unroll") for (int k = 0; k < 2; ++k) dst[n][k] = *(const PG8_LAS bf16x8*)(lds + PG8_SB(b, h) + boff + n * 2048 + k * 1024); } while (0)
#define PG8_MMA(ai, bj, At, Bt) do { __builtin_amdgcn_s_setprio(1); _Pragma("unroll") for (int m = 0; m < 4; ++m) _Pragma("unroll") for (int n = 0; n < 2; ++n) _Pragma("unroll") for (int k = 0; k < 2; ++k) \
        acc[ai][bj][m][n] = __builtin_amdgcn_mfma_f32_16x16x32_bf16(Bt[n][k], At[m][k], acc[ai][bj][m][n], 0, 0, 0); __builtin_amdgcn_s_setprio(0); } while (0)
#define PG8_WAIT_V(n) asm volatile("s_waitcnt vmcnt(" #n ")" ::: "memory")
#define PG8_WAIT_L(n) asm volatile("s_waitcnt lgkmcnt(" #n ")" ::: "memory")
#define PG8_BAR __builtin_amdgcn_s_barrier()
#define PG8_SCHED __builtin_amdgcn_sched_barrier(0)
    Unit cur, nxt; int ui = 0;
    if (!S.next(0, cur)) return;
    f32x4 acc[2][2][4][2];
#pragma unroll
    for (int a = 0; a < 2; ++a)
#pragma unroll
        for (int b = 0; b < 2; ++b)
#pragma unroll
            for (int m = 0; m < 4; ++m)
#pragma unroll
                for (int n = 0; n < 2; ++n) acc[a][b][m][n] = (f32x4){0.f, 0.f, 0.f, 0.f};
    bf16x8 At[4][2], B0[2][2], B1[2][2];
    const char* cA = (const char*)g.A + (size_t)cur.pm * tstep; const char* cB = (const char*)g.Bt + (size_t)cur.pn * tstep;
    S.a_ready(cur);
    if constexpr (SP2) {
        PG8_STAGE(PG8_SB(0, 0), cB, voffB); PG8_STAGE(PG8_SB(0, 1), cB + hstep, voffB); PG8_STAGE(PG8_SA(0, 0), cA, voffA); PG8_STAGE(PG8_SA(0, 1), cA + hstep, voffA);
        if (wr == 1) PG8_BAR;
        PG8_WAIT_V(2); PG8_BAR;
        PG8_STAGE(PG8_SB(1, 0), cB + kstep, voffB); PG8_STAGE(PG8_SA(1, 0), cA + kstep, voffA); PG8_STAGE(PG8_SB(1, 1), cB + hstep + kstep, voffB);
        PG8_WAIT_V(6); PG8_BAR;
    } else {
        PG8_STAGE(PG8_SB(0, 0), cB, voffB); PG8_STAGE(PG8_SA(0, 0), cA, voffA); PG8_STAGE(PG8_SB(0, 1), cB + hstep, voffB); PG8_STAGE(PG8_SA(0, 1), cA + hstep, voffA);
        if (wr == 1) PG8_BAR;
        PG8_WAIT_V(4); PG8_BAR;
        PG8_STAGE(PG8_SB(1, 0), cB + kstep, voffB); PG8_STAGE(PG8_SA(1, 0), cA + kstep, voffA); PG8_STAGE(PG8_SB(1, 1), cB + hstep + kstep, voffB);
        PG8_WAIT_V(6); PG8_BAR;
    }
    for (;;) {
        const bool has_next = S.next(ui + 1, nxt);
        const char* nA = has_next ? (const char*)g.A + (size_t)nxt.pm * tstep : cA; const char* nB = has_next ? (const char*)g.Bt + (size_t)nxt.pn * tstep : cB;
        for (int t = 0; t < nt; t += 2) {
            const bool last = (t == nt - 2);
            const char* a1 = cA + (size_t)(t + 1) * kstep;
            const char* a2 = last ? nA : cA + (size_t)(t + 2) * kstep; const char* b2 = last ? nB : cB + (size_t)(t + 2) * kstep;
            const char* a3 = a2 + kstep; const char* b3 = b2 + kstep;
            if (last && has_next) S.a_ready(nxt);
            if constexpr (SP2) {
            PG8_LDB(B0, 0, 0); PG8_LDB(B1, 0, 1); PG8_SCHED; PG8_LDA(At, 0, 0); PG8_STAGE(PG8_SA(1, 1), a1 + hstep, voffA);
            PG8_WAIT_V(8); PG8_WAIT_L(0); PG8_BAR; PG8_MMA(0, 0, At, B0); PG8_MMA(0, 1, At, B1); PG8_BAR; PG8_SCHED;
            PG8_LDA(At, 0, 1); PG8_STAGE(PG8_SB(0, 0), b2, voffB); PG8_STAGE(PG8_SB(0, 1), b2 + hstep, voffB); PG8_STAGE(PG8_SA(0, 0), a2, voffA);
            PG8_WAIT_V(8); PG8_WAIT_L(0); PG8_BAR; PG8_MMA(1, 0, At, B0); PG8_MMA(1, 1, At, B1); PG8_BAR; PG8_SCHED;
            PG8_LDB(B0, 1, 0); PG8_LDB(B1, 1, 1); PG8_SCHED; PG8_LDA(At, 1, 0); PG8_STAGE(PG8_SA(0, 1), a2 + hstep, voffA);
            PG8_WAIT_V(8); PG8_WAIT_L(0); PG8_BAR; PG8_MMA(0, 0, At, B0); PG8_MMA(0, 1, At, B1); PG8_BAR; PG8_SCHED;
            PG8_LDA(At, 1, 1); PG8_STAGE(PG8_SB(1, 0), b3, voffB); PG8_STAGE(PG8_SB(1, 1), b3 + hstep, voffB); PG8_STAGE(PG8_SA(1, 0), a3, voffA);
            PG8_WAIT_V(8); PG8_WAIT_L(0); PG8_BAR; PG8_MMA(1, 0, At, B0); PG8_MMA(1, 1, At, B1); PG8_BAR; PG8_SCHED;
            } else {
            PG8_LDB(B0, 0, 0); PG8_SCHED; PG8_LDA(At, 0, 0); PG8_STAGE(PG8_SA(1, 1), a1 + hstep, voffA);
            PG8_WAIT_L(8); PG8_BAR; PG8_WAIT_L(0); PG8_MMA(0, 0, At, B0); PG8_BAR; PG8_SCHED;
            PG8_LDB(B1, 0, 1); PG8_STAGE(PG8_SB(0, 0), b2, voffB);
            PG8_BAR; PG8_WAIT_L(0); PG8_MMA(0, 1, At, B1); PG8_BAR;
            PG8_LDA(At, 0, 1); PG8_STAGE(PG8_SA(0, 0), a2, voffA);
            PG8_BAR; PG8_WAIT_L(0); PG8_MMA(1, 0, At, B0); PG8_BAR; PG8_SCHED;
            PG8_STAGE(PG8_SB(0, 1), b2 + hstep, voffB);
            PG8_WAIT_V(6); PG8_BAR; PG8_MMA(1, 1, At, B1); PG8_BAR;
            PG8_LDB(B0, 1, 0); PG8_SCHED; PG8_LDA(At, 1, 0); PG8_STAGE(PG8_SA(0, 1), a2 + hstep, voffA);
            PG8_WAIT_L(8); PG8_BAR; PG8_WAIT_L(0); PG8_MMA(0, 0, At, B0); PG8_BAR; PG8_SCHED;
            PG8_LDB(B1, 1, 1); PG8_STAGE(PG8_SB(1, 0), b3, voffB);
            PG8_BAR; PG8_WAIT_L(0); PG8_MMA(0, 1, At, B1); PG8_BAR;
            PG8_LDA(At, 1, 1); PG8_STAGE(PG8_SA(1, 0), a3, voffA);
            PG8_BAR; PG8_WAIT_L(0); PG8_MMA(1, 0, At, B0); PG8_BAR; PG8_SCHED;
            PG8_STAGE(PG8_SB(1, 1), b3 + hstep, voffB);
            PG8_WAIT_V(6); PG8_BAR; PG8_MMA(1, 1, At, B1); PG8_BAR;
            }
        }
        if constexpr (ALIGN_EPI) { if (wr == 0) PG8_BAR; }
        if constexpr (!Epi::AFTER_DRAIN) { E(acc, cur, wr, wc, fr, fq);
#ifdef REP_EPI
            if constexpr (Epi::PERM) { asm volatile("" ::: "memory"); E(acc, cur, wr, wc, fr, fq); }
#endif
            S.done(cur); }
        if (!has_next) break;
#pragma unroll
        for (int a = 0; a < 2; ++a)
#pragma unroll
            for (int b = 0; b < 2; ++b)
#pragma unroll
                for (int m = 0; m < 4; ++m)
#pragma unroll
                    for (int n = 0; n < 2; ++n) acc[a][b][m][n] = (f32x4){0.f, 0.f, 0.f, 0.f};
        cur = nxt; cA = nA; cB = nB; ++ui;
        if constexpr (ALIGN_EPI) { if (wr == 1) PG8_BAR; }
    }
    PG8_WAIT_V(0);
    if constexpr (!ALIGN_EPI) { if (wr == 0) PG8_BAR; }
    PG8_BAR;
    if constexpr (Epi::AFTER_DRAIN) { E.fused(acc, cur, wr, wc, fr, fq, lds, wid, lane); S.done(cur); }
#undef PG8_SA
#undef PG8_SB
#undef PG8_STAGE
#undef PG8_LDA
#undef PG8_LDB
#undef PG8_MMA
#undef PG8_WAIT_V
#undef PG8_WAIT_L
#undef PG8_BAR
#undef PG8_SCHED
}
}

#define LAS __attribute__((address_space(3)))
typedef unsigned short bf16;
typedef unsigned v4u __attribute__((ext_vector_type(4)));
typedef unsigned v2u __attribute__((ext_vector_type(2)));
typedef float f32x4 __attribute__((ext_vector_type(4)));
typedef float f32x2 __attribute__((ext_vector_type(2)));
typedef short bf16x8 __attribute__((ext_vector_type(8)));
typedef short s16x4 __attribute__((ext_vector_type(4)));
typedef short v4i16_t __attribute__((ext_vector_type(4)));
typedef __bf16 bf16x2_t __attribute__((ext_vector_type(2)));

constexpr int M_TOK = 16384, DM = 2048, FF = 8192, NPROJ = 6144, GLA_LD = 6160;
constexpr float EPS = 1e-6f, LOG2E = 1.4426950408889634f;
constexpr size_t MiB = 1u << 20;
constexpr size_t WS_SSQ = 0;
constexpr size_t WS_HSSQ = 256 * 1024;
constexpr size_t WS_WZT = 512 * 1024;
constexpr size_t WS_QK0 = 576 * 1024;
constexpr size_t WS_BAR = 704 * 1024;
constexpr size_t WS_DEC = 1 * MiB;
constexpr size_t WS_QK0P = 2 * MiB;
constexpr size_t WS_WIN = 4 * MiB, WS_WO = 28 * MiB, WS_WUP = 36 * MiB, WS_WDN = 68 * MiB;
constexpr size_t WS_XB = 100 * MiB;
constexpr size_t WS_U = 164 * MiB;
constexpr size_t WS_PROJ = 164 * MiB;
constexpr size_t WS_OG = 356 * MiB;
constexpr size_t WS_HPART = 420 * MiB;
constexpr size_t WS_END = 428 * MiB;
constexpr int LDS_BYTES = 147456;

#define LDS_WAIT() asm volatile("s_waitcnt lgkmcnt(0)" ::: "memory")
#define LBAR() do { asm volatile("s_waitcnt lgkmcnt(0)" ::: "memory"); __builtin_amdgcn_s_barrier(); asm volatile("" ::: "memory"); } while (0)

__device__ __forceinline__ unsigned pk2(float lo, float hi) { f32x2 v = {lo, hi}; bf16x2_t b = __builtin_convertvector(v, bf16x2_t); return __builtin_bit_cast(unsigned, b); }
__device__ __forceinline__ unsigned short f2bf(float f) { return (unsigned short)(pk2(f, 0.f) & 0xffffu); }
__device__ __forceinline__ float bflo(unsigned u) { return __uint_as_float(u << 16); }
__device__ __forceinline__ float bfhi(unsigned u) { return __uint_as_float(u & 0xffff0000u); }
__device__ __forceinline__ float wave_sum(float v) {
#pragma unroll
    for (int o = 1; o < 64; o <<= 1) v += __shfl_xor(v, o);
    return v;
}
__device__ __forceinline__ float dpp_sum16(float v) {
    v += __int_as_float(__builtin_amdgcn_update_dpp(0, __float_as_int(v), 0xB1, 0xF, 0xF, false));
    v += __int_as_float(__builtin_amdgcn_update_dpp(0, __float_as_int(v), 0x4E, 0xF, 0xF, false));
    v += __int_as_float(__builtin_amdgcn_update_dpp(0, __float_as_int(v), 0x141, 0xF, 0xF, false));
    v += __int_as_float(__builtin_amdgcn_update_dpp(0, __float_as_int(v), 0x140, 0xF, 0xF, false));
    return v;
}
__device__ __forceinline__ float xrow_sum(float v) {
    auto a = __builtin_amdgcn_permlane16_swap(__float_as_uint(v), __float_as_uint(v), false, false);
    v = __uint_as_float(a[0]) + __uint_as_float(a[1]);
    auto b = __builtin_amdgcn_permlane32_swap(__float_as_uint(v), __float_as_uint(v), false, false);
    return __uint_as_float(b[0]) + __uint_as_float(b[1]);
}
__device__ __forceinline__ float xrow_max(float v) {
    auto a = __builtin_amdgcn_permlane16_swap(__float_as_uint(v), __float_as_uint(v), false, false);
    v = fmaxf(__uint_as_float(a[0]), __uint_as_float(a[1]));
    auto b = __builtin_amdgcn_permlane32_swap(__float_as_uint(v), __float_as_uint(v), false, false);
    return fmaxf(__uint_as_float(b[0]), __uint_as_float(b[1]));
}
__device__ __forceinline__ s16x4 tr_read(const LAS unsigned char* p) { return __builtin_bit_cast(s16x4, __builtin_amdgcn_ds_read_tr16_b64_v4i16((LAS v4i16_t*)p)); }
__device__ __forceinline__ bf16x8 cat8(s16x4 a, s16x4 b) { return (bf16x8){a[0], a[1], a[2], a[3], b[0], b[1], b[2], b[3]}; }
__device__ __forceinline__ bf16x8 pack8(f32x4 a, f32x4 b) { v4u w; w.x = pk2(a[0], a[1]); w.y = pk2(a[2], a[3]); w.z = pk2(b[0], b[1]); w.w = pk2(b[2], b[3]); return __builtin_bit_cast(bf16x8, w); }
#define MFMA16(a, b, c) __builtin_amdgcn_mfma_f32_16x16x32_bf16((a), (b), (c), 0, 0, 0)

struct ConvTile { const float* src; const float* gk; bf16* dst; int ldw, K; };
__device__ __forceinline__ ConvTile conv_tile(int t, const float* Win, int ldwin, const float* gmix, const float* Wo, const float* Wup, const float* gmlp, const float* Wdn, unsigned char* ws) {
    constexpr int T_IN = 16 * 48, T_O = 16 * 16, T_UP = 16 * 64;
    ConvTile c;
    if (t < T_IN) { const int kb = t / 48, nb = t % 48; c.src = Win + (size_t)(128 * kb) * ldwin + 128 * nb; c.gk = gmix + 128 * kb; c.dst = (bf16*)(ws + WS_WIN) + (size_t)(128 * nb) * 2048 + 128 * kb; c.ldw = ldwin; c.K = 2048; return c; }
    t -= T_IN;
    if (t < T_O) { const int kb = t / 16, nb = t % 16; c.src = Wo + (size_t)(128 * kb) * 2048 + 128 * nb; c.gk = nullptr; c.dst = (bf16*)(ws + WS_WO) + (size_t)(128 * nb) * 2048 + 128 * kb; c.ldw = 2048; c.K = 2048; return c; }
    t -= T_O;
    if (t < T_UP) { const int kb = t / 64, nb = t % 64; c.src = Wup + (size_t)(128 * kb) * 8192 + 128 * nb; c.gk = gmlp + 128 * kb; c.dst = (bf16*)(ws + WS_WUP) + (size_t)(128 * nb) * 2048 + 128 * kb; c.ldw = 8192; c.K = 2048; return c; }
    t -= T_UP;
    { const int kb = t / 16, nb = t % 16; c.src = Wdn + (size_t)(128 * kb) * 2048 + 128 * nb; c.gk = nullptr; c.dst = (bf16*)(ws + WS_WDN) + (size_t)(128 * nb) * 8192 + 128 * kb; c.ldw = 2048; c.K = 8192; return c; }
}
__device__ __forceinline__ void convert_weights(const float* Win, int ldwin, const float* gmix, const float* Wo, const float* Wup, const float* gmlp, const float* Wdn,
                                                unsigned char* ws, LAS unsigned char* lds, int tid, int G) {
    asm volatile("" : "+v"(tid));
    constexpr int NT = 16 * 48 + 16 * 16 + 16 * 64 + 64 * 16;
    LAS float* scr = (LAS float*)lds;
    const int lr = tid >> 5, lc = (tid & 31) * 4;
    const int oc = tid & 15, on = tid >> 4;
    f32x4 r[8]; float gv[8];
    int t = blockIdx.x;
    if (t < NT) { const ConvTile c = conv_tile(t, Win, ldwin, gmix, Wo, Wup, gmlp, Wdn, ws);
#pragma unroll
        for (int i = 0; i < 8; ++i) { r[i] = __builtin_nontemporal_load((const f32x4*)(c.src + (size_t)(lr + 16 * i) * c.ldw + lc)); gv[i] = c.gk ? c.gk[lr + 16 * i] : 1.f; } }
    for (; t < NT; t += G) {
        const ConvTile c = conv_tile(t, Win, ldwin, gmix, Wo, Wup, gmlp, Wdn, ws);
        __syncthreads();
#pragma unroll
        for (int i = 0; i < 8; ++i) { LAS float* p = scr + (lr + 16 * i) * 129 + lc; p[0] = r[i][0] * gv[i]; p[1] = r[i][1] * gv[i]; p[2] = r[i][2] * gv[i]; p[3] = r[i][3] * gv[i]; }
        __syncthreads();
        if (t + G < NT) { const ConvTile cn = conv_tile(t + G, Win, ldwin, gmix, Wo, Wup, gmlp, Wdn, ws);
#pragma unroll
            for (int i = 0; i < 8; ++i) { r[i] = __builtin_nontemporal_load((const f32x4*)(cn.src + (size_t)(lr + 16 * i) * cn.ldw + lc)); gv[i] = cn.gk ? cn.gk[lr + 16 * i] : 1.f; } }
#pragma unroll
        for (int i = 0; i < 4; ++i) { const int n = on + 32 * i; const LAS float* sp = scr + (8 * oc) * 129 + n;
            v4u o; o.x = pk2(sp[0 * 129], sp[1 * 129]); o.y = pk2(sp[2 * 129], sp[3 * 129]); o.z = pk2(sp[4 * 129], sp[5 * 129]); o.w = pk2(sp[6 * 129], sp[7 * 129]);
            *(v4u*)(c.dst + (size_t)n * c.K + 8 * oc) = o; }
    }
    __syncthreads();
}

__device__ __forceinline__ float log_sigmoid(float x) { return fminf(x, 0.f) - __logf(1.f + __expf(-fabsf(x))); }
__device__ __forceinline__ void gla_prep(LAS unsigned char* lds, const bf16* xb, const bf16* WzT, const float* ssq0, const float* Wg, const float* bg, bf16* proj, float* dec,
                                         int tid, int lane, int w) {
    asm volatile("" : "+v"(tid), "+v"(lane)); asm volatile("" : "+s"(w));
    LAS float* zp = (LAS float*)lds;
    LAS float* zs = (LAS float*)(lds + 32768);
    const int g = lane >> 4, i16 = lane & 15;
    for (int unit = blockIdx.x; unit < 256; unit += gridDim.x) {
        const int tok0 = unit * 64;
        f32x4 za[4];
#pragma unroll
        for (int mt = 0; mt < 4; ++mt) za[mt] = (f32x4){0.f, 0.f, 0.f, 0.f};
#pragma unroll
        for (int ks = 0; ks < 8; ++ks) {
            const int k = w * 256 + ks * 32 + g * 8;
            const bf16x8 bf = *(const bf16x8*)(WzT + i16 * 2048 + k);
#pragma unroll
            for (int mt = 0; mt < 4; ++mt) { const bf16x8 af = *(const bf16x8*)(xb + (size_t)(tok0 + mt * 16 + i16) * 2048 + k); za[mt] = MFMA16(af, bf, za[mt]); }
        }
#pragma unroll
        for (int mt = 0; mt < 4; ++mt)
#pragma unroll
            for (int j = 0; j < 4; ++j) zp[(w * 64 + mt * 16 + 4 * g + j) * 16 + i16] = za[mt][j];
        __syncthreads();
#pragma unroll
        for (int e = 0; e < 2; ++e) { const int idx = tid + 512 * e, row = idx >> 4; float s = 0.f;
#pragma unroll
            for (int ww = 0; ww < 8; ++ww) s += zp[ww * 1024 + idx];
            zs[idx] = s * __builtin_amdgcn_rsqf(ssq0[tok0 + row] * (1.0f / 2048.0f) + EPS); }
        __syncthreads();
        const int c0 = 2 * tid;
        float wg0[16], wg1[16];
#pragma unroll
        for (int j = 0; j < 16; ++j) { const f32x2 t = *(const f32x2*)(Wg + j * 1024 + c0); wg0[j] = t.x; wg1[j] = t.y; }
        const f32x2 bgv = *(const f32x2*)(bg + c0);
        float b0 = 0.f, b1 = 0.f;
        unsigned* qp = (unsigned*)(proj + (size_t)tok0 * NPROJ + c0);
        unsigned q2[8], k2[8], q2n[8], k2n[8];
#pragma unroll
        for (int u = 0; u < 8; ++u) { const unsigned* p = qp + (size_t)u * (NPROJ / 2); q2[u] = p[0]; k2[u] = p[512]; }
        for (int t0 = 0; t0 < 64; t0 += 8) {
            if (t0 + 8 < 64) {
#pragma unroll
                for (int u = 0; u < 8; ++u) { const unsigned* p = qp + (size_t)(t0 + 8 + u) * (NPROJ / 2); q2n[u] = p[0]; k2n[u] = p[512]; }
            }
            asm volatile("" ::: "memory");
#pragma unroll
            for (int u = 0; u < 8; ++u) {
                const int t = t0 + u;
                float l0 = bgv.x, l1 = bgv.y;
#pragma unroll
                for (int j4 = 0; j4 < 4; ++j4) { const f32x4 z = *(const LAS f32x4*)(zs + t * 16 + j4 * 4);
#pragma unroll
                    for (int e = 0; e < 4; ++e) { l0 += z[e] * wg0[j4 * 4 + e]; l1 += z[e] * wg1[j4 * 4 + e]; } }
                b0 += log_sigmoid(l0) * (1.0f / 16.0f); b1 += log_sigmoid(l1) * (1.0f / 16.0f);
                unsigned* p = qp + (size_t)t * (NPROJ / 2);
                const float e0 = __expf(b0), e1 = __expf(b1), i0 = __expf(-b0), i1 = __expf(-b1);
                p[0] = pk2(bflo(q2[u]) * 0.0625f * e0, bfhi(q2[u]) * 0.0625f * e1);
                p[512] = pk2(bflo(k2[u]) * i0, bfhi(k2[u]) * i1);
            }
            asm volatile("" ::: "memory");
#pragma unroll
            for (int u = 0; u < 8; ++u) { q2[u] = q2n[u]; k2[u] = k2n[u]; }
        }
        *(f32x2*)(dec + (size_t)unit * 1024 + c0) = (f32x2){__expf(b0), __expf(b1)};
        __syncthreads();
    }
}

__device__ __forceinline__ void gla_scan(LAS unsigned char* lds, const bf16* proj, const float* dec, const float* qk0, const float* ssq0, bf16* og, float* hssq, int tid, int lane, int w) {
    asm volatile("" : "+v"(tid), "+v"(lane)); asm volatile("" : "+s"(w));
    constexpr int QS = 528, VS = 144, XS = 272;
    constexpr int QD = 0, KI = 33792, VV = 67584, AB = 76800, XO = 86016, DC = 103424;
    const int g = lane >> 4, i16 = lane & 15, dvt = w & 3, half = w >> 2;
    for (int unit = blockIdx.x; unit < 256; unit += gridDim.x) {
        const int xcd = unit & 7, uidx = unit >> 3, bh = xcd * 4 + (uidx >> 3), b = bh >> 2, h = bh & 3, js = uidx & 7;
        f32x4 S[8];
#pragma unroll
        for (int i = 0; i < 8; ++i) S[i] = (f32x4){0.f, 0.f, 0.f, 0.f};
        { float a00; f32x4 q4 = (f32x4){0.f, 0.f, 0.f, 0.f}, k4 = (f32x4){0.f, 0.f, 0.f, 0.f};
#pragma unroll
          for (int kq = 0; kq < 8; ++kq) { q4 = q4 + *(const f32x4*)(qk0 + (size_t)(kq * 8 + b) * 2048 + h * 256 + lane * 4); k4 = k4 + *(const f32x4*)(qk0 + (size_t)(kq * 8 + b) * 2048 + 1024 + h * 256 + lane * 4); }
          const float r2 = 1.0f / (ssq0[b * 2048] * (1.0f / 2048.0f) + EPS);
          a00 = wave_sum((q4[0] * k4[0] + q4[1] * k4[1]) + (q4[2] * k4[2] + q4[3] * k4[3])) * 0.0625f * r2;
          if (tid == 0) *(LAS float*)(lds + DC + 1024) = a00; }
        const int lrow = tid >> 5, lch = tid & 31, vrow = tid >> 3, vch = tid & 7;
        const bf16* pq = proj + (size_t)(b * 2048 + lrow) * NPROJ + h * 256 + lch * 8;
        const bf16* pv = proj + (size_t)(b * 2048 + vrow) * NPROJ + 2048 + h * 512 + js * 64 + vch * 8;
        const float* pd = dec + (size_t)(b * 32) * 1024 + h * 256 + (tid & 255);
        f32x4 ofin[4];
#pragma unroll
        for (int ct = 0; ct < 4; ++ct) ofin[ct] = (f32x4){0.f, 0.f, 0.f, 0.f};
#define SCAN_FLUSH(NP) do { const int tokb = b * 2048 + (NP) * 64; \
            _Pragma("unroll") for (int ct = 0; ct < 4; ++ct) _Pragma("unroll") for (int j = 0; j < 4; ++j) { \
                const int c = ct * 16 + 4 * g + j; const float v = ofin[ct][j]; \
                og[(size_t)(tokb + c) * DM + h * 512 + js * 64 + dvt * 16 + i16] = f2bf(v); \
                const float s = dpp_sum16(v * v); \
                if (i16 == 0) hssq[((size_t)(tokb + c) * 4 + h) * 32 + js * 4 + dvt] = s; } } while (0)
        v4u rq[4], rk[4], rv; float rd;
#pragma unroll
        for (int i = 0; i < 4; ++i) { rq[i] = *(const v4u*)(pq + (size_t)(16 * i) * NPROJ); rk[i] = *(const v4u*)(pq + (size_t)(16 * i) * NPROJ + 1024); }
        rv = *(const v4u*)pv; rd = pd[0];
        for (int n = 0; n < 32; ++n) {
            LBAR();
#pragma unroll
            for (int i = 0; i < 4; ++i) { *(LAS v4u*)(lds + QD + (lrow + 16 * i) * QS + lch * 16) = rq[i]; *(LAS v4u*)(lds + KI + (lrow + 16 * i) * QS + lch * 16) = rk[i]; }
            *(LAS v4u*)(lds + VV + vrow * VS + vch * 16) = rv;
            if (tid < 256) *(LAS float*)(lds + DC + tid * 4) = rd;
            LBAR();
            if (n + 1 < 32) {
                const size_t adv = (size_t)(n + 1) * 64 * NPROJ;
#pragma unroll
                for (int i = 0; i < 4; ++i) { rq[i] = *(const v4u*)(pq + adv + (size_t)(16 * i) * NPROJ); rk[i] = *(const v4u*)(pq + adv + (size_t)(16 * i) * NPROJ + 1024); }
                rv = *(const v4u*)(pv + adv); rd = pd[(n + 1) * 1024];
            }
            if (half == 0 && n > 0) { SCAN_FLUSH(n - 1); }
            {
                const int ct = w >> 1;
#pragma unroll
                for (int tt = 0; tt < 2; ++tt) {
                    const int st = (w & 1) * 2 + tt;
                    f32x4 a = (f32x4){0.f, 0.f, 0.f, 0.f};
                    if (st <= ct) {
                        bf16x8 af[8], bfr[8];
#pragma unroll
                        for (int ks = 0; ks < 8; ++ks) {
                            af[ks] = *(const LAS bf16x8*)(lds + QD + (ct * 16 + i16) * QS + ks * 64 + g * 16);
                            bfr[ks] = *(const LAS bf16x8*)(lds + KI + (st * 16 + i16) * QS + ks * 64 + g * 16);
                        }
                        asm volatile("" ::: "memory");
#pragma unroll
                        for (int ks = 0; ks < 8; ++ks) a = MFMA16(af[ks], bfr[ks], a);
                    }
#pragma unroll
                    for (int j = 0; j < 4; ++j) { const int c = ct * 16 + 4 * g + j, s = st * 16 + i16; float v = (s <= c) ? a[j] : 0.f;
                        if (n == 0 && c == 0 && s == 0) v = *(const LAS float*)(lds + DC + 1024);
                        *(LAS unsigned short*)(lds + AB + c * VS + s * 2) = f2bf(v); }
                }
            }
            f32x4 o[4];
#pragma unroll
            for (int ct = 0; ct < 4; ++ct) o[ct] = (f32x4){0.f, 0.f, 0.f, 0.f};
            {
                s16x4 qlo[4][4], qhi[4][4];
#pragma unroll
                for (int p = 0; p < 4; ++p) {
                    const int dkA = (half * 8 + 2 * p) * 16 + 4 * g;
#pragma unroll
                    for (int ct = 0; ct < 4; ++ct) {
                        qlo[p][ct] = *(const LAS s16x4*)(lds + QD + (ct * 16 + i16) * QS + dkA * 2);
                        qhi[p][ct] = *(const LAS s16x4*)(lds + QD + (ct * 16 + i16) * QS + (dkA + 16) * 2);
                    }
                }
                asm volatile("" ::: "memory");
#pragma unroll
                for (int p = 0; p < 4; ++p) {
                    const bf16x8 sf = pack8(S[2 * p], S[2 * p + 1]);
#pragma unroll
                    for (int ct = 0; ct < 4; ++ct) o[ct] = MFMA16(cat8(qlo[p][ct], qhi[p][ct]), sf, o[ct]);
                }
            }
            LBAR();
            bf16x8 vf0, vf1;
            { const LAS unsigned char* va = lds + VV + (8 * g + (i16 >> 2)) * VS + (dvt * 16 + 4 * (i16 & 3)) * 2;
              vf0 = cat8(tr_read(va), tr_read(va + 4 * VS)); vf1 = cat8(tr_read(va + 32 * VS), tr_read(va + 36 * VS)); }
            { const bf16x8 vh = half ? vf1 : vf0; bf16x8 af[4];
#pragma unroll
              for (int ct = 0; ct < 4; ++ct) af[ct] = *(const LAS bf16x8*)(lds + AB + (ct * 16 + i16) * VS + (half * 32 + 8 * g) * 2);
              asm volatile("" ::: "memory");
#pragma unroll
              for (int ct = 0; ct < 4; ++ct) o[ct] = MFMA16(af[ct], vh, o[ct]); }
#pragma unroll
            for (int ib = 0; ib < 2; ++ib) {
                s16x4 kt[4][4]; f32x4 dd[4];
#pragma unroll
                for (int ii = 0; ii < 4; ++ii) {
                    const int dk0 = (half * 8 + ib * 4 + ii) * 16;
                    const LAS unsigned char* ka = lds + KI + (8 * g + (i16 >> 2)) * QS + (dk0 + 4 * (i16 & 3)) * 2;
                    kt[ii][0] = tr_read(ka); kt[ii][1] = tr_read(ka + 4 * QS); kt[ii][2] = tr_read(ka + 32 * QS); kt[ii][3] = tr_read(ka + 36 * QS);
                    dd[ii] = *(const LAS f32x4*)(lds + DC + (dk0 + 4 * g) * 4);
                }
                asm volatile("" ::: "memory");
#pragma unroll
                for (int ii = 0; ii < 4; ++ii) {
                    const int i = ib * 4 + ii;
                    S[i] = MFMA16(cat8(kt[ii][0], kt[ii][1]), vf0, S[i]); S[i] = MFMA16(cat8(kt[ii][2], kt[ii][3]), vf1, S[i]);
                    S[i] = S[i] * dd[ii];
                }
            }
            if (half == 1) {
#pragma unroll
                for (int ct = 0; ct < 4; ++ct)
#pragma unroll
                    for (int j = 0; j < 4; ++j) *(LAS float*)(lds + XO + (ct * 16 + 4 * g + j) * XS + (dvt * 16 + i16) * 4) = o[ct][j];
            }
            LBAR();
            if (half == 0) {
#pragma unroll
                for (int ct = 0; ct < 4; ++ct)
#pragma unroll
                    for (int j = 0; j < 4; ++j) ofin[ct][j] = o[ct][j] + *(const LAS float*)(lds + XO + (ct * 16 + 4 * g + j) * XS + (dvt * 16 + i16) * 4);
            }
        }
        if (half == 0) { SCAN_FLUSH(31); }
        __syncthreads();
    }
#undef SCAN_FLUSH
}

__device__ __forceinline__ void gla_finalize(bf16* og, const bf16* proj, const float* hssq, const float* gout, int gtid, int nthr) {
    asm volatile("" : "+v"(gtid));
#define FIN_LOAD(IDX, ov, rv, rs, g0, g1) const int tok##IDX = (IDX) >> 8, c##IDX = ((IDX) & 255) * 8; \
        const v4u ov = *(const v4u*)(og + (size_t)tok##IDX * DM + c##IDX); const v4u rv = *(const v4u*)(proj + (size_t)tok##IDX * NPROJ + 4096 + c##IDX); \
        float hs##IDX = 0.f; { const f32x4* hp_ = (const f32x4*)(hssq + ((size_t)tok##IDX * 4 + (c##IDX >> 9)) * 32); \
          _Pragma("unroll") for (int q_ = 0; q_ < 8; ++q_) { const f32x4 t_ = hp_[q_]; hs##IDX += (t_[0] + t_[1]) + (t_[2] + t_[3]); } } \
        const float rs = __builtin_amdgcn_rsqf(hs##IDX * (1.0f / 512.0f) + EPS); \
        const f32x4 g0 = *(const f32x4*)(gout + c##IDX), g1 = *(const f32x4*)(gout + c##IDX + 4);
#define FIN_STORE(IDX, ov, rv, rs, g0, g1) { \
        float ovf[8] = {bflo(ov.x), bfhi(ov.x), bflo(ov.y), bfhi(ov.y), bflo(ov.z), bfhi(ov.z), bflo(ov.w), bfhi(ov.w)}; \
        float rvf[8] = {bflo(rv.x), bfhi(rv.x), bflo(rv.y), bfhi(rv.y), bflo(rv.z), bfhi(rv.z), bflo(rv.w), bfhi(rv.w)}; \
        float gg[8] = {g0[0], g0[1], g0[2], g0[3], g1[0], g1[1], g1[2], g1[3]}; float res[8]; \
        _Pragma("unroll") for (int e = 0; e < 8; ++e) { const float r = rvf[e]; res[e] = ovf[e] * rs * gg[e] * (r / (1.f + __expf(-r))); } \
        v4u w; w.x = pk2(res[0], res[1]); w.y = pk2(res[2], res[3]); w.z = pk2(res[4], res[5]); w.w = pk2(res[6], res[7]); \
        *(v4u*)(og + (size_t)tok##IDX * DM + c##IDX) = w; }
    for (int idx = gtid; idx < M_TOK * 256; idx += 4 * nthr) {
        const int idxa = idx, idxb = idx + nthr, idxc = idx + 2 * nthr, idxd = idx + 3 * nthr;
        FIN_LOAD(idxa, ova, rva, rsa, g0a, g1a)
        FIN_LOAD(idxb, ovb, rvb, rsb, g0b, g1b)
        FIN_LOAD(idxc, ovc, rvc, rsc, g0c, g1c)
        FIN_LOAD(idxd, ovd, rvd, rsd, g0d, g1d)
        asm volatile("" ::: "memory");
        FIN_STORE(idxa, ova, rva, rsa, g0a, g1a)
        FIN_STORE(idxb, ovb, rvb, rsb, g0b, g1b)
        FIN_STORE(idxc, ovc, rvc, rsc, g0c, g1c)
        FIN_STORE(idxd, ovd, rvd, rsd, g0d, g1d)
    }
#undef FIN_LOAD
#undef FIN_STORE
}

__device__ __forceinline__ void attn_phase(LAS unsigned char* lds, const bf16* qkv, const float* gq, const float* gk, const float* relb, bf16* ao, int tid, int lane, int w) {
    asm volatile("" : "+v"(tid), "+v"(lane)); asm volatile("" : "+s"(w));
    constexpr int KS = 272, VS = 288, KBUF = 64 * KS, VBUF = 64 * VS, VB0 = 2 * KBUF, BT = VB0 + 2 * VBUF;
    const int g = lane >> 4, i16 = lane & 15;
    const int srow = tid >> 4, sch = tid & 15;
    v4u qr[4], rk0, rk1, rv0, rv1;
#define ATT_QPTR(UNIT) (qkv + (size_t)((((UNIT) & 127) >> 4) * 2048 + (2 * ((UNIT) >> 7) + (w >> 2)) * 64 + (w & 3) * 16 + i16) * NPROJ + ((UNIT) & 15) * 128 + g * 8)
#define ATT_KBASE(UNIT) (qkv + (size_t)((((UNIT) & 127) >> 4) * 2048 + srow) * NPROJ + 2048 + ((UNIT) & 15) * 128 + sch * 8)
#define ATT_KCLO(UNIT) ((2 * ((UNIT) >> 7) - 8 > 0) ? (2 * ((UNIT) >> 7) - 8) : 0)
#define ATT_LOADP(KB, kc) do { const bf16* p_ = (KB) + (size_t)(kc) * 64 * NPROJ; rk0 = *(const v4u*)p_; rk1 = *(const v4u*)(p_ + (size_t)32 * NPROJ); \
                          rv0 = *(const v4u*)(p_ + 2048); rv1 = *(const v4u*)(p_ + (size_t)32 * NPROJ + 2048); } while (0)
    if ((int)blockIdx.x < 2048) { const int un_ = blockIdx.x; const bf16* qp_ = ATT_QPTR(un_);
#pragma unroll
        for (int ks = 0; ks < 4; ++ks) qr[ks] = *(const v4u*)(qp_ + ks * 32);
        ATT_LOADP(ATT_KBASE(un_), ATT_KCLO(un_)); }
    int hprev = -1;
    f32x4 gqa[4], gqb[4];
#pragma unroll
    for (int ks = 0; ks < 4; ++ks) {
        gqa[ks] = *(const f32x4*)(gq + ks * 32 + g * 8) * *(const f32x4*)(gk + ks * 32 + g * 8) * (0.08838834764831845f * LOG2E);
        gqb[ks] = *(const f32x4*)(gq + ks * 32 + g * 8 + 4) * *(const f32x4*)(gk + ks * 32 + g * 8 + 4) * (0.08838834764831845f * LOG2E); }
    for (int unit = blockIdx.x; unit < 2048; unit += gridDim.x) {
        const int nunit = unit + (int)gridDim.x;
        const int u = unit >> 7, bh = unit & 127, b = bh >> 4, h = bh & 15;
        const int n0 = 2 * u, nq = n0 + (w >> 2);
        if (h != hprev) { if (tid < 320) *(LAS float*)(lds + BT + tid * 4) = relb[h * 320 + tid] * LOG2E; hprev = h; }
        bf16x8 qf[4];
        {
            float ss = 0.f;
#pragma unroll
            for (int ks = 0; ks < 4; ++ks) {
                const float a0 = bflo(qr[ks].x), a1 = bfhi(qr[ks].x), a2 = bflo(qr[ks].y), a3 = bfhi(qr[ks].y), a4 = bflo(qr[ks].z), a5 = bfhi(qr[ks].z), a6 = bflo(qr[ks].w), a7 = bfhi(qr[ks].w);
                ss += (a0 * a0 + a1 * a1) + (a2 * a2 + a3 * a3) + (a4 * a4 + a5 * a5) + (a6 * a6 + a7 * a7); }
            ss = xrow_sum(ss);
            const float rs = __builtin_amdgcn_rsqf(ss * (1.0f / 128.0f) + EPS);
#pragma unroll
            for (int ks = 0; ks < 4; ++ks) {
                const f32x4 ga = gqa[ks], gb = gqb[ks];
                v4u o; o.x = pk2(bflo(qr[ks].x) * rs * ga[0], bfhi(qr[ks].x) * rs * ga[1]); o.y = pk2(bflo(qr[ks].y) * rs * ga[2], bfhi(qr[ks].y) * rs * ga[3]);
                o.z = pk2(bflo(qr[ks].z) * rs * gb[0], bfhi(qr[ks].z) * rs * gb[1]); o.w = pk2(bflo(qr[ks].w) * rs * gb[2], bfhi(qr[ks].w) * rs * gb[3]);
                qf[ks] = __builtin_bit_cast(bf16x8, o);
            }
        }
        const int kc_lo = (n0 - 8 > 0) ? (n0 - 8) : 0, ntiles = n0 + 2 - kc_lo;
        const bf16* kbase = qkv + (size_t)(b * 2048 + srow) * NPROJ + 2048 + h * 128 + sch * 8;
#define ATT_LOAD(kc) do { const bf16* p_ = kbase + (size_t)(kc) * 64 * NPROJ; rk0 = *(const v4u*)p_; rk1 = *(const v4u*)(p_ + (size_t)32 * NPROJ); \
                          rv0 = *(const v4u*)(p_ + 2048); rv1 = *(const v4u*)(p_ + (size_t)32 * NPROJ + 2048); } while (0)
#define ATT_KNORM(r, dstrow, buf) do { \
            const float a0 = bflo(r.x), a1 = bfhi(r.x), a2 = bflo(r.y), a3 = bfhi(r.y), a4 = bflo(r.z), a5 = bfhi(r.z), a6 = bflo(r.w), a7 = bfhi(r.w); \
            float s_ = (a0 * a0 + a1 * a1) + (a2 * a2 + a3 * a3) + (a4 * a4 + a5 * a5) + (a6 * a6 + a7 * a7); \
            s_ = dpp_sum16(s_); \
            const float rs_ = __builtin_amdgcn_rsqf(s_ * (1.0f / 128.0f) + EPS); v4u o_; \
            o_.x = pk2(a0 * rs_, a1 * rs_); o_.y = pk2(a2 * rs_, a3 * rs_); o_.z = pk2(a4 * rs_, a5 * rs_); o_.w = pk2(a6 * rs_, a7 * rs_); \
            *(LAS v4u*)(lds + (buf) * KBUF + (dstrow) * KS + sch * 16) = o_; } while (0)
#define ATT_WRITE(buf) do { ATT_KNORM(rk0, srow, buf); ATT_KNORM(rk1, srow + 32, buf); \
            *(LAS v4u*)(lds + VB0 + (buf) * VBUF + srow * VS + sch * 16) = rv0; *(LAS v4u*)(lds + VB0 + (buf) * VBUF + (srow + 32) * VS + sch * 16) = rv1; } while (0)
        ATT_WRITE(0);
        ATT_LOAD(kc_lo + 1);
        LBAR();
        f32x4 OT[8];
#pragma unroll
        for (int dt = 0; dt < 8; ++dt) OT[dt] = (f32x4){0.f, 0.f, 0.f, 0.f};
        float mrun = -1e30f, lrun = 0.f;
        const int qi = (w & 3) * 16 + i16;
        for (int t = 0; t < ntiles; ++t) {
            const int kc = kc_lo + t, buf = t & 1;
            if (t + 1 < ntiles) ATT_WRITE(buf ^ 1);
            if (t + 2 < ntiles) ATT_LOAD(kc + 2);
            if (t == ntiles - 1 && nunit < 2048) { const bf16* qp_ = ATT_QPTR(nunit);
#pragma unroll
                for (int ks = 0; ks < 4; ++ks) qr[ks] = *(const v4u*)(qp_ + ks * 32);
                ATT_LOADP(ATT_KBASE(nunit), ATT_KCLO(nunit)); }
            if (kc >= nq - 8 && kc <= nq) {
                const LAS unsigned char* Kb = lds + buf * KBUF;
                const LAS unsigned char* Vb = lds + VB0 + buf * VBUF;
                f32x4 s[4];
                {
                    bf16x8 kf[4][4];
#pragma unroll
                    for (int kt = 0; kt < 4; ++kt)
#pragma unroll
                        for (int ks = 0; ks < 4; ++ks) kf[kt][ks] = *(const LAS bf16x8*)(Kb + (kt * 16 + i16) * KS + ks * 64 + g * 16);
                    asm volatile("" ::: "memory");
#pragma unroll
                    for (int kt = 0; kt < 4; ++kt) s[kt] = (f32x4){0.f, 0.f, 0.f, 0.f};
#pragma unroll
                    for (int ks = 0; ks < 4; ++ks)
#pragma unroll
                        for (int kt = 0; kt < 4; ++kt) s[kt] = MFMA16(kf[kt][ks], qf[ks], s[kt]);
                }
                const int dchunk = nq - kc;
                if (dchunk >= 5) {
                    const float bc = *(const LAS float*)(lds + BT + 319 * 4);
#pragma unroll
                    for (int kt = 0; kt < 4; ++kt) s[kt] = s[kt] + bc;
                } else if (dchunk <= 3) {
                    const LAS float* bp = (const LAS float*)(lds + BT) + (dchunk * 64 + qi - 4 * g + 12);
#pragma unroll
                    for (int kt = 0; kt < 4; ++kt)
#pragma unroll
                        for (int j = 0; j < 4; ++j) s[kt][j] += bp[51 - kt * 16 - j];
                } else {
                    const int dbase = dchunk * 64 + qi - 4 * g + 63;
#pragma unroll
                    for (int kt = 0; kt < 4; ++kt)
#pragma unroll
                        for (int j = 0; j < 4; ++j) { int idx = dbase - kt * 16 - j; idx = idx < 0 ? 0 : (idx > 319 ? 319 : idx); s[kt][j] += *(const LAS float*)(lds + BT + idx * 4); }
                }
                float mx = fmaxf(fmaxf(s[0][0], s[0][1]), fmaxf(s[0][2], s[0][3]));
#pragma unroll
                for (int kt = 1; kt < 4; ++kt) mx = fmaxf(mx, fmaxf(fmaxf(s[kt][0], s[kt][1]), fmaxf(s[kt][2], s[kt][3])));
                mx = xrow_max(mx);
                const float mnew = fmaxf(mrun, mx), alpha = __builtin_amdgcn_exp2f(mrun - mnew);
                mrun = mnew;
                float rsum = 0.f;
#pragma unroll
                for (int kt = 0; kt < 4; ++kt)
#pragma unroll
                    for (int j = 0; j < 4; ++j) { const float p = __builtin_amdgcn_exp2f(s[kt][j] - mnew); s[kt][j] = p; rsum += p; }
                rsum = xrow_sum(rsum);
                lrun = lrun * alpha + rsum;
#pragma unroll
                for (int dt = 0; dt < 8; ++dt) OT[dt] = OT[dt] * alpha;
                const bf16x8 pf0 = pack8(s[0], s[1]), pf1 = pack8(s[2], s[3]);
                const LAS unsigned char* va = Vb + (4 * g + (i16 >> 2)) * VS + (4 * (i16 & 3)) * 2;
#pragma unroll
                for (int db = 0; db < 2; ++db) {
                    s16x4 vt[4][4];
#pragma unroll
                    for (int dd = 0; dd < 4; ++dd) { const int dt = db * 4 + dd;
                        vt[dd][0] = tr_read(va + dt * 32); vt[dd][1] = tr_read(va + 16 * VS + dt * 32); vt[dd][2] = tr_read(va + 32 * VS + dt * 32); vt[dd][3] = tr_read(va + 48 * VS + dt * 32); }
                    asm volatile("" ::: "memory");
#pragma unroll
                    for (int dd = 0; dd < 4; ++dd) { const int dt = db * 4 + dd;
                        OT[dt] = MFMA16(cat8(vt[dd][0], vt[dd][1]), pf0, OT[dt]); OT[dt] = MFMA16(cat8(vt[dd][2], vt[dd][3]), pf1, OT[dt]); }
                }
            }
            LBAR();
        }
        {
            const float inv = 1.0f / lrun;
            bf16* op = ao + (size_t)(b * 2048 + nq * 64 + qi) * DM + h * 128 + 4 * g;
#pragma unroll
            for (int dt = 0; dt < 8; ++dt) { v2u o; o.x = pk2(OT[dt][0] * inv, OT[dt][1] * inv); o.y = pk2(OT[dt][2] * inv, OT[dt][3] * inv); *(v2u*)(op + dt * 16) = o; }
        }
    }
#undef ATT_LOAD
#undef ATT_LOADP
#undef ATT_QPTR
#undef ATT_KBASE
#undef ATT_KCLO
#undef ATT_KNORM
#undef ATT_WRITE
}

#define RLX_AGENT __ATOMIC_RELAXED, __HIP_MEMORY_SCOPE_AGENT
#define XB_TMO      128
#define XB_XCNT(j)  (256  + 64 * (j))
#define XB_XSUB(j)  (1280 + 64 * (j))
#define XB_XGEN(j)  (2304 + 64 * (j))
#define XB_TOP      3328
#define XB_TOPGEN   3392
#define XCD_BAR_WORDS 3456
#define XB_SPIN_CAP (1u << 18)

__device__ __forceinline__ unsigned xb_ld(unsigned* p)              { return __hip_atomic_load(p, __ATOMIC_RELAXED, __HIP_MEMORY_SCOPE_AGENT); }
__device__ __forceinline__ unsigned xb_add(unsigned* p, unsigned v) { return __hip_atomic_fetch_add(p, v, __ATOMIC_RELAXED, __HIP_MEMORY_SCOPE_AGENT); }
__device__ __forceinline__ unsigned xb_xcc_id() { return (unsigned)__builtin_amdgcn_s_getreg((3 << 11) | 20) & 0xFu; }
#define XB_SPIN(cond, bar) do { unsigned _sp = 0; while (cond) { __builtin_amdgcn_s_sleep(1); \
    if ((++_sp & 255u) == 0u) { if (xb_ld(&(bar)[XB_TMO])) break; if (_sp > XB_SPIN_CAP) { atomicAdd(&(bar)[XB_TMO], 1u); break; } } } } while (0)

struct XcdBarrier {
    unsigned* bar; unsigned x;
    volatile LAS unsigned* st;
};

__device__ __forceinline__ XcdBarrier xcd_barrier_post(unsigned* bar, volatile LAS unsigned* st) {
    XcdBarrier b; b.bar = bar; b.x = xb_xcc_id(); b.st = st;
    if (threadIdx.x == 0) (void)xb_add(&bar[XB_XCNT(b.x)], 1u);
    return b;
}
__device__ __forceinline__ void xcd_barrier_complete(unsigned* bar, unsigned x, unsigned& nloc, unsigned& nx) {
    const unsigned G = gridDim.x * gridDim.y * gridDim.z;
    unsigned sum, cnt, mine, sp = 0u;
    for (;;) {
        sum = 0u; cnt = 0u; mine = 0u;
#pragma unroll
        for (unsigned j = 0; j < 16; ++j) { const unsigned c = xb_ld(&bar[XB_XCNT(j)]); sum += c; cnt += (c > 0u) ? 1u : 0u; mine = (j == x) ? c : mine; }
        if (sum == G) break;
        __builtin_amdgcn_s_sleep(1);
        if ((++sp & 255u) == 0u) { if (xb_ld(&bar[XB_TMO])) break; if (sp > XB_SPIN_CAP) { atomicAdd(&bar[XB_TMO], 1u); break; } }
    }
    nloc = mine > 0u ? mine : 1u; nx = cnt > 0u ? cnt : 1u;
}

__device__ __forceinline__ void xcd_barrier(const XcdBarrier& b) {
    asm volatile("s_waitcnt vmcnt(0)" ::: "memory");
    __syncthreads();
    if (threadIdx.x == 0) {
        unsigned* bar = b.bar;
        __builtin_amdgcn_s_waitcnt(0);
        unsigned nloc = b.st[0], nx = b.st[1];
        if (nloc == 0u) { xcd_barrier_complete(bar, b.x, nloc, nx); b.st[0] = nloc; b.st[1] = nx; }
        const unsigned old = xb_add(&bar[XB_XSUB(b.x)], 1u);
        const unsigned gen = old / nloc;
        if (old + 1u == (gen + 1u) * nloc) {
            __builtin_amdgcn_fence(__ATOMIC_RELEASE, "agent");
            asm volatile("s_waitcnt vmcnt(0)" ::: "memory");
            const unsigned og = xb_add(&bar[XB_TOP], 1u);
            const unsigned tg = og / nx;
            if (og + 1u == (tg + 1u) * nx) xb_add(&bar[XB_TOPGEN], 1u);
            else XB_SPIN(xb_ld(&bar[XB_TOPGEN]) == tg, bar);
            __builtin_amdgcn_fence(__ATOMIC_ACQUIRE, "agent");
            xb_add(&bar[XB_XGEN(b.x)], 1u);
            asm volatile("s_waitcnt vmcnt(0)" ::: "memory");
        } else {
            XB_SPIN(xb_ld(&bar[XB_XGEN(b.x)]) == gen, bar);
            __builtin_amdgcn_fence(__ATOMIC_ACQUIRE, "agent");
            asm volatile("s_waitcnt vmcnt(0)" ::: "memory");
        }
    }
    __syncthreads();
}

struct Args { const float* in[15]; float* out; unsigned char* ws; };
typedef const __attribute__((address_space(4))) unsigned char* kptr_t;
__device__ __forceinline__ kptr_t kfresh(kptr_t p) { asm volatile("" : "+s"(p)); return p; }
#define KIN(i) (*(const float* const __attribute__((address_space(4)))*)(kfresh(kargp) + 8 * (i)))
#define KOUT() ((float*)*(const float* const __attribute__((address_space(4)))*)(kfresh(kargp) + 120))
#define KWS() ((unsigned char*)*(const float* const __attribute__((address_space(4)))*)(kfresh(kargp) + 128))
__global__ void __launch_bounds__(512, 2) mega_fwd(Args args) {
    extern __shared__ __attribute__((aligned(16))) unsigned char lds_raw[];
    cg::grid_group grid = cg::this_grid();
    LAS unsigned char* lds = (LAS unsigned char*)lds_raw;
    const kptr_t kargp = (kptr_t)__builtin_amdgcn_kernarg_segment_ptr();
#define PHASE_IDS() int tid = threadIdx.x; asm volatile("" : "+v"(tid)); const int lane = tid & 63, wave = __builtin_amdgcn_readfirstlane(tid >> 6); \
    const int gw = blockIdx.x * 8 + wave, gtid = blockIdx.x * 512 + tid; (void)lane; (void)wave; (void)gw; (void)gtid;
    if (threadIdx.x < 4) ((volatile LAS unsigned*)(lds + 140000))[threadIdx.x] = 0u;
    __syncthreads();
    const XcdBarrier xbar = xcd_barrier_post((unsigned*)(KWS() + WS_BAR), (volatile LAS unsigned*)(lds + 140000));
#define GSYNC() xcd_barrier(xbar)
    const int G = gridDim.x, NGW = G * 8, nthr = G * 512;

#pragma unroll
    for (int L = 0; L < 2; ++L) {
        if (L == 0) {
            PHASE_IDS()
            unsigned char* ws = KWS();
            const float* Win = KIN(3); const float* gm = KIN(1); const float* x = KIN(0);
#ifdef REP_CONV
            int reps = 2; asm volatile("" : "+s"(reps));
            for (int rep = 0; rep < reps; ++rep)
#endif
            convert_weights(Win, GLA_LD, gm, KIN(7), KIN(13), KIN(2), KIN(14), ws, lds, tid, G);
            bf16* WzT = (bf16*)(ws + WS_WZT); float* ssq = (float*)(ws + WS_SSQ); float* hssq = (float*)(ws + WS_HSSQ); bf16* xb = (bf16*)(ws + WS_XB);
            for (int i = gtid; i < 16 * 2048; i += nthr) { const int j = i >> 11, k = i & 2047; WzT[j * 2048 + k] = f2bf(Win[(size_t)k * GLA_LD + 6144 + j] * gm[k]); }
            for (int i = gtid; i < 3 * 16384; i += nthr) ssq[16384 + i] = 0.f;
            for (int i = gtid; i < 4 * 16384; i += nthr) hssq[i] = 0.f;
            for (int m = gw; m < M_TOK; m += 2 * NGW) {
                const int m2 = m + NGW;
                const f32x4* xr = (const f32x4*)(x + (size_t)m * DM) + lane; const f32x4* xr2 = (const f32x4*)(x + (size_t)m2 * DM) + lane;
                f32x4 v[8], v2[8]; float s = 0.f, s2 = 0.f;
#pragma unroll
                for (int j = 0; j < 8; ++j) v[j] = __builtin_nontemporal_load(xr + 64 * j);
#pragma unroll
                for (int j = 0; j < 8; ++j) v2[j] = __builtin_nontemporal_load(xr2 + 64 * j);
#pragma unroll
                for (int j = 0; j < 8; ++j) { s += (v[j].x * v[j].x + v[j].y * v[j].y) + (v[j].z * v[j].z + v[j].w * v[j].w); s2 += (v2[j].x * v2[j].x + v2[j].y * v2[j].y) + (v2[j].z * v2[j].z + v2[j].w * v2[j].w); }
                s = wave_sum(s); s2 = wave_sum(s2); if (lane == 0) { ssq[m] = s; ssq[m2] = s2; }
                unsigned long long* o8 = (unsigned long long*)(xb + (size_t)m * DM) + lane; unsigned long long* o82 = (unsigned long long*)(xb + (size_t)m2 * DM) + lane;
#pragma unroll
                for (int j = 0; j < 8; ++j) { o8[64 * j] = (unsigned long long)pk2(v[j].x, v[j].y) | ((unsigned long long)pk2(v[j].z, v[j].w) << 32);
                                              o82[64 * j] = (unsigned long long)pk2(v2[j].x, v2[j].y) | ((unsigned long long)pk2(v2[j].z, v2[j].w) << 32); }
            }
            __syncthreads();
            for (int u = blockIdx.x; u < 256; u += G) {
                const int cgp = u & 31, kq = u >> 5;
                LAS float* xs = (LAS float*)lds;
                for (int i = tid; i < 2048; i += 512) { const int bb = i >> 8, kk = i & 255; xs[i] = x[(size_t)bb * 2048 * DM + kq * 256 + kk] * gm[kq * 256 + kk]; }
                __syncthreads();
                const int col = cgp * 64 + lane;
                const float* wp = Win + (size_t)(kq * 256) * GLA_LD + col;
                float acc = 0.f;
#pragma unroll 32
                for (int k = 0; k < 256; ++k) acc += xs[wave * 256 + k] * wp[(size_t)k * GLA_LD];
                ((float*)(ws + WS_QK0P))[(size_t)(kq * 8 + wave) * 2048 + col] = acc;
                __syncthreads();
            }
        } else {
            PHASE_IDS()
            convert_weights(KIN(8), NPROJ, KIN(1) + DM, KIN(12), KIN(13) + (size_t)DM * FF, KIN(2) + DM, KIN(14) + (size_t)FF * DM, KWS(), lds, tid, G);
        }
        __syncthreads();
        if (G > 0x3fffffff) grid.sync();
        GSYNC();
#ifdef REP_SYNC
        for (int rep = 0; rep < 5; ++rep) GSYNC();
#endif
        {
            unsigned char* ws = KWS();
            pg8::Gemm gm{(const bf16*)(ws + WS_XB), (const bf16*)(ws + WS_WIN), M_TOK, NPROJ, DM}; pg8::StaticOrder S; S.init(M_TOK, NPROJ, G, (int)blockIdx.x);
            pg8::EpiBf16S<0> E{(bf16*)(ws + WS_PROJ), NPROJ, (const float*)(ws + WS_SSQ) + (L == 0 ? 0 : 2 * 16384)};
#ifdef REP_INPROJ
            int reps = 2; asm volatile("" : "+s"(reps));
            for (int rep = 0; rep < reps; ++rep)
#endif
            pg8::gemm_phase<pg8::EpiBf16S<0>, pg8::StaticOrder, true, true>(lds, gm, S, E);
        }
        GSYNC();
        if (L == 0) {
            { PHASE_IDS() unsigned char* ws = KWS();
              gla_prep(lds, (const bf16*)(ws + WS_XB), (const bf16*)(ws + WS_WZT), (const float*)(ws + WS_SSQ), KIN(4), KIN(5), (bf16*)(ws + WS_PROJ), (float*)(ws + WS_DEC), tid, lane, wave);
            }
            GSYNC();
            { PHASE_IDS() unsigned char* ws = KWS();
#ifdef REP_SCAN
              int reps = 2; asm volatile("" : "+s"(reps));
              for (int rep = 0; rep < reps; ++rep)
              gla_scan(lds, (const bf16*)(ws + WS_PROJ), (const float*)(ws + WS_DEC), (const float*)(ws + WS_QK0P), (const float*)(ws + WS_SSQ), (bf16*)(ws + WS_OG), (float*)(ws + (rep == 0 ? WS_HPART : WS_END)), tid, lane, wave);
#else
              gla_scan(lds, (const bf16*)(ws + WS_PROJ), (const float*)(ws + WS_DEC), (const float*)(ws + WS_QK0P), (const float*)(ws + WS_SSQ), (bf16*)(ws + WS_OG), (float*)(ws + WS_HPART), tid, lane, wave);
#endif
            }
            GSYNC();
            { PHASE_IDS() unsigned char* ws = KWS();
              gla_finalize((bf16*)(ws + WS_OG), (const bf16*)(ws + WS_PROJ), (const float*)(ws + WS_HPART), KIN(6), gtid, nthr);
            }
        } else {
            PHASE_IDS()
            unsigned char* ws = KWS();
#ifdef REP_ATTN
            int reps = 2; asm volatile("" : "+s"(reps));
            for (int rep = 0; rep < reps; ++rep)
#endif
            attn_phase(lds, (const bf16*)(ws + WS_PROJ), KIN(9), KIN(10), KIN(11), (bf16*)(ws + WS_OG), tid, lane, wave);
        }
        __syncthreads();
        GSYNC();
        {
            unsigned char* ws = KWS(); float* out = KOUT();
            pg8::Gemm gm{(const bf16*)(ws + WS_OG), (const bf16*)(ws + WS_WO), M_TOK, DM, DM}; pg8::StaticOrder S; S.init(M_TOK, DM, G, (int)blockIdx.x);
            pg8::EpiRes E{(bf16*)(ws + WS_XB), out, (float*)(ws + WS_SSQ) + (L == 0 ? 1 : 3) * 16384, DM, 0};
            pg8::gemm_phase<pg8::EpiRes, pg8::StaticOrder, false, true>(lds, gm, S, E);
        }
        GSYNC();
        {
            unsigned char* ws = KWS();
            pg8::Gemm gm{(const bf16*)(ws + WS_XB), (const bf16*)(ws + WS_WUP), M_TOK, FF, DM}; pg8::StaticOrder S; S.init(M_TOK, FF, G, (int)blockIdx.x);
            pg8::EpiBf16S<1> E{(bf16*)(ws + WS_U), FF, (const float*)(ws + WS_SSQ) + (L == 0 ? 1 : 3) * 16384};
#ifdef REP_UP
            int reps = 2; asm volatile("" : "+s"(reps));
            for (int rep = 0; rep < reps; ++rep)
#endif
            pg8::gemm_phase<pg8::EpiBf16S<1>, pg8::StaticOrder, true, true>(lds, gm, S, E);
        }
        GSYNC();
        {
            unsigned char* ws = KWS(); float* out = KOUT();
            pg8::Gemm gm{(const bf16*)(ws + WS_U), (const bf16*)(ws + WS_WDN), M_TOK, DM, FF}; pg8::StaticOrder S; S.init(M_TOK, DM, G, (int)blockIdx.x, 4);
            pg8::EpiRes E{(bf16*)(ws + WS_XB), out, (float*)(ws + WS_SSQ) + 2 * 16384, DM, L == 0 ? 0 : 1};
            pg8::gemm_phase<pg8::EpiRes, pg8::StaticOrder, false, true>(lds, gm, S, E);
        }
        if (L == 0) GSYNC();
    }
}

extern "C" void kernel_launch(void* const* d_in, const int* in_sizes, int n_in, void* d_out, int out_size, void* d_ws, size_t ws_size, hipStream_t stream) {
    static int grid = 0;
    if (grid == 0) {
        if (n_in != 15 || out_size != M_TOK * DM || ws_size < WS_END) { fprintf(stderr, "kernel_launch: unexpected shapes (n_in %d, out %d, ws %zu)\n", n_in, out_size, ws_size); grid = -1; return; }
        int dev = 0, cus = 0, per_cu = 0;
        (void)hipGetDevice(&dev);
        (void)hipDeviceGetAttribute(&cus, hipDeviceAttributeMultiprocessorCount, dev);
        (void)hipFuncSetAttribute((const void*)mega_fwd, hipFuncAttributeMaxDynamicSharedMemorySize, LDS_BYTES);
        (void)hipOccupancyMaxActiveBlocksPerMultiprocessor(&per_cu, (const void*)mega_fwd, 512, LDS_BYTES);
        if (per_cu < 1) per_cu = 1;
        if (cus < 1) cus = 256;
        (void)hipGetLastError();
        grid = cus * per_cu;
    }
    if (grid < 0) return;
    if (hipMemsetAsync((char*)d_ws + WS_BAR, 0, 16384, stream) != hipSuccess) { fprintf(stderr, "kernel_launch: memset failed\n"); return; }
    Args a{};
    for (int i = 0; i < 15; ++i) a.in[i] = (const float*)d_in[i];
    a.out = (float*)d_out; a.ws = (unsigned char*)d_ws;
    void* kargs[] = {&a};
    hipError_t e = hipLaunchCooperativeKernel((const void*)mega_fwd, dim3(grid), dim3(512), kargs, LDS_BYTES, stream);
    if (e != hipSuccess) fprintf(stderr, "cooperative launch failed: %s (grid %d)\n", hipGetErrorString(e), grid);
}
```

```cpp
#include <hip/hip_runtime.h>
#include <hip/hip_cooperative_groups.h>
#include <cstdio>
#include <cstdint>
namespace cg = cooperative_groups;

namespace pg8 {
#define PG8_LAS __attribute__((address_space(3)))
typedef unsigned short bf16_t;
typedef short bf16x8 __attribute__((ext_vector_type(8)));
typedef float f32x4 __attribute__((ext_vector_type(4)));
typedef unsigned u32x4 __attribute__((ext_vector_type(4)));
constexpr int BM = 256, BK = 64, HALF = 128, HTB = HALF * BK * 2  , STAGE_BYTES = 8 * HTB, NXCD = 8, WGM = 8;

__host__ __device__ __forceinline__ int lds_byte(int r, int c) { const int st = (r >> 4) * 2 + (c >> 5), rr = r & 15, cc = c & 31, ob = rr * 64 + cc * 2; return st * 1024 + (ob ^ (((ob >> 9) & 1) << 5)); }
__host__ __device__ __forceinline__ void stage_rc(int b, int& R, int& C) { const int st = b / 1024, sb = b % 1024, swz = sb ^ (((sb >> 9) & 1) << 5); R = (st >> 1) * 16 + swz / 64; C = (st & 1) * 32 + (swz % 64) / 2; }
__host__ __device__ __forceinline__ int perm32(int rho) { const int n = rho >> 4, i = rho & 15; return 8 * (i >> 2) + 4 * n + (i & 3); }

struct Unit { int pm, pn; };
struct Gemm { const bf16_t* A; const bf16_t* Bt; int M, N, K; };

struct StaticOrder {
    int nM, nN, nwg, G, c, wgm;
    __host__ __device__ void init(int M, int N, int G_, int c_, int wgm_ = WGM) { nM = M / BM; nN = N / BM; nwg = nM * nN; G = G_; c = c_; wgm = wgm_; }
    __host__ __device__ bool next(int i, Unit& u) const {
        const long L = (long)i * G + c; if (L >= nwg) return false;
        int wgid = (int)L; { const int q = nwg / NXCD, r = nwg % NXCD, xcd = wgid % NXCD, off = wgid / NXCD; wgid = (xcd < r ? xcd * (q + 1) : r * (q + 1) + (xcd - r) * q) + off; }
        const int nig = wgm * nN, gid = wgid / nig, fm = gid * wgm, gsz = (nM - fm) < wgm ? (nM - fm) : wgm;
        u.pm = fm + ((wgid % nig) % gsz); u.pn = (wgid % nig) / gsz; return true;
    }
    __device__ __forceinline__ void a_ready(const Unit&) const {}
    __device__ __forceinline__ void done(const Unit&) const {}
};

__device__ __forceinline__ unsigned cvt_pk_bf16(float lo, float hi) { unsigned r; asm volatile("v_cvt_pk_bf16_f32 %0, %1, %2" : "=v"(r) : "v"(lo), "v"(hi)); return r; }
typedef float f32x2 __attribute__((ext_vector_type(2)));
typedef unsigned u32x2 __attribute__((ext_vector_type(2)));
template <int ACT> struct EpiBf16S {
    static constexpr bool PERM = true, AFTER_DRAIN = false;
    bf16_t* O; int ldc; const float* ssq;
    __device__ __forceinline__ void operator()(const f32x4 (&acc)[2][2][4][2], const Unit& u, int wr, int wc, int fr, int fq) const {
        const int row0 = u.pm * BM + wr * 64 + fr; const int col0 = u.pn * BM + wc * 32 + 8 * fq;
        float sv[2][4];
#pragma unroll
        for (int ai = 0; ai < 2; ++ai)
#pragma unroll
            for (int m = 0; m < 4; ++m) sv[ai][m] = ssq[row0 + ai * HALF + m * 16];
        asm volatile("" ::: "memory");
#pragma unroll
        for (int ai = 0; ai < 2; ++ai)
#pragma unroll
            for (int m = 0; m < 4; ++m) {
                const int row = row0 + ai * HALF + m * 16;
                const float rs = __builtin_amdgcn_rsqf(sv[ai][m] * (1.0f / 2048.0f) + 1e-6f);
                bf16_t* rowp = O + (size_t)row * ldc + col0;
#pragma unroll
                for (int bj = 0; bj < 2; ++bj) {
                    f32x4 v0 = acc[ai][bj][m][0] * rs, v1 = acc[ai][bj][m][1] * rs;
                    if (ACT == 1) {
#pragma unroll
                        for (int e = 0; e < 4; ++e) { float a = fmaxf(v0[e], 0.f); v0[e] = a * a; float b = fmaxf(v1[e], 0.f); v1[e] = b * b; }
                    }
                    u32x4 w; w.x = cvt_pk_bf16(v0[0], v0[1]); w.y = cvt_pk_bf16(v0[2], v0[3]); w.z = cvt_pk_bf16(v1[0], v1[1]); w.w = cvt_pk_bf16(v1[2], v1[3]);
                    *(u32x4*)(rowp + bj * HALF) = w;
                }
            }
    }
};
struct EpiRes {
    static constexpr bool PERM = false, AFTER_DRAIN = false;
    bf16_t* xb; float* outf; float* ssq; int ldc; int fin;
    __device__ __forceinline__ void operator()(const f32x4 (&acc)[2][2][4][2], const Unit& u, int wr, int wc, int fr, int fq) const {
        const int row0 = u.pm * BM + wr * 64 + fr; const int col0 = u.pn * BM + wc * 32 + 4 * fq;
#pragma unroll
        for (int ai = 0; ai < 2; ++ai) {
            u32x2 bv[4][2][2];
#pragma unroll
            for (int m = 0; m < 4; ++m) { const size_t off = (size_t)(row0 + ai * HALF + m * 16) * ldc + col0;
#pragma unroll
                for (int bj = 0; bj < 2; ++bj)
#pragma unroll
                    for (int n = 0; n < 2; ++n) bv[m][bj][n] = *(const u32x2*)(xb + off + bj * HALF + n * 16); }
            asm volatile("" ::: "memory");
#pragma unroll
            for (int m = 0; m < 4; ++m) {
                const int row = row0 + ai * HALF + m * 16;
                const size_t off = (size_t)row * ldc + col0;
                float s = 0.f;
#pragma unroll
                for (int bj = 0; bj < 2; ++bj)
#pragma unroll
                    for (int n = 0; n < 2; ++n) {
                        const size_t c = off + bj * HALF + n * 16;
                        const u32x2 w0 = bv[m][bj][n];
                        const f32x4 b = {__uint_as_float(w0.x << 16), __uint_as_float(w0.x & 0xffff0000u), __uint_as_float(w0.y << 16), __uint_as_float(w0.y & 0xffff0000u)};
                        const f32x4 o = b + acc[ai][bj][m][n];
                        if (fin) { *(f32x4*)(outf + c) = o; }
                        else { u32x2 w; w.x = cvt_pk_bf16(o[0], o[1]); w.y = cvt_pk_bf16(o[2], o[3]); *(u32x2*)(xb + c) = w;
                               s += (o[0] * o[0] + o[1] * o[1]) + (o[2] * o[2] + o[3] * o[3]); }
                    }
                if (!fin) { s += __shfl_xor(s, 16); s += __shfl_xor(s, 32); if (fq == 0) unsafeAtomicAdd(ssq + row, s); }
            }
            asm volatile("" ::: "memory");
        }
    }
};

template <class Epi, class Sched, bool ALIGN_EPI = false, bool SP2 = false>
__device__ __forceinline__ void gemm_phase(PG8_LAS unsigned char* lds, const Gemm g, const Sched& S, const Epi& E) {
    int tid_ = threadIdx.x; asm volatile("" : "+v"(tid_));
    const int tid = tid_, wid = __builtin_amdgcn_readfirstlane(tid >> 6), lane = tid & 63, wr = wid >> 2, wc = wid & 3, fr = lane & 15, fq = lane >> 4;
    const int K = g.K, nt = K / BK;
    unsigned voffA[2], voffB[2];
#pragma unroll
    for (int i = 0; i < 2; ++i) { int R, C; stage_rc(tid * 16 + i * 8192, R, C); const int Rb = Epi::PERM ? ((R & ~31) + perm32(R & 31)) : R;
        voffA[i] = (unsigned)(R * K + C) * 2u; voffB[i] = (unsigned)(Rb * K + C) * 2u; }
    const size_t kstep = (size_t)(BK * 2);
    const size_t hstep = (size_t)HALF * K * 2;
    const size_t tstep = 2 * hstep;
    const unsigned ldsw = (unsigned)wid * 1024u;
    const int aoff = lds_byte(wr * 64 + fr, fq * 8), boff = lds_byte(wc * 32 + fr, fq * 8);
#define PG8_SA(b, h) (((b) * 2 + (h)) * HTB)
#define PG8_SB(b, h) ((4 + (b) * 2 + (h)) * HTB)
#define PG8_STAGE(bufoff, gbase, voff) do { _Pragma("unroll") for (int _i = 0; _i < 2; ++_i) \
        __builtin_amdgcn_global_load_lds((const unsigned*)((const char*)(gbase) + (voff)[_i]), (PG8_LAS unsigned*)(lds + (bufoff) + ldsw + _i * 8192), 16, 0, 0); } while (0)
#define PG8_LDA(dst, b, h) do { _Pragma("unroll") for (int m = 0; m < 4; ++m) _Pragma("unroll") for (int k = 0; k < 2; ++k) dst[m][k] = *(const PG8_LAS bf16x8*)(lds + PG8_SA(b, h) + aoff + m * 2048 + k * 1024); } while (0)
#define PG8_LDB(dst, b, h) do { _Pragma("unroll") for (int n = 0; n < 2; ++n) _Pragma("unroll") for (int k = 0; k < 2; ++k) dst[n][k] = *(const PG8_LAS bf16x8*)(lds + PG8_SB(b, h) + boff + n * 2048 + k * 1024); } while (0)
#define PG8_MMA(ai, bj, At, Bt) do { __builtin_amdgcn_s_setprio(1); _Pragma("unroll") for (int m = 0; m < 4; ++m) _Pragma("unroll") for (int n = 0; n < 2; ++n) _Pragma("unroll") for (int k = 0; k < 2; ++k) \
        acc[ai][bj][m][n] = __builtin_amdgcn_mfma_f32_16x16x32_bf16(Bt[n][k], At[m][k], acc[ai][bj][m][n], 0, 0, 0); __builtin_amdgcn_s_setprio(0); } while (0)
#define PG8_WAIT_V(n) asm volatile("s_waitcnt vmcnt(" #n ")" ::: "memory")
#define PG8_WAIT_L(n) asm volatile("s_waitcnt lgkmcnt(" #n ")" ::: "memory")
#define PG8_BAR __builtin_amdgcn_s_barrier()
#define PG8_SCHED __builtin_amdgcn_sched_barrier(0)
    Unit cur, nxt; int ui = 0;
    if (!S.next(0, cur)) return;
    f32x4 acc[2][2][4][2];
#pragma unroll
    for (int a = 0; a < 2; ++a)
#pragma unroll
        for (int b = 0; b < 2; ++b)
#pragma unroll
            for (int m = 0; m < 4; ++m)
#pragma unroll
                for (int n = 0; n < 2; ++n) acc[a][b][m][n] = (f32x4){0.f, 0.f, 0.f, 0.f};
    bf16x8 At[4][2], B0[2][2], B1[2][2];
    const char* cA = (const char*)g.A + (size_t)cur.pm * tstep; const char* cB = (const char*)g.Bt + (size_t)cur.pn * tstep;
    S.a_ready(cur);
    if constexpr (SP2) {
        PG8_STAGE(PG8_SB(0, 0), cB, voffB); PG8_STAGE(PG8_SB(0, 1), cB + hstep, voffB); PG8_STAGE(PG8_SA(0, 0), cA, voffA); PG8_STAGE(PG8_SA(0, 1), cA + hstep, voffA);
        if (wr == 1) PG8_BAR;
        PG8_WAIT_V(2); PG8_BAR;
        PG8_STAGE(PG8_SB(1, 0), cB + kstep, voffB); PG8_STAGE(PG8_SA(1, 0), cA + kstep, voffA); PG8_STAGE(PG8_SB(1, 1), cB + hstep + kstep, voffB);
        PG8_WAIT_V(6); PG8_BAR;
    } else {
        PG8_STAGE(PG8_SB(0, 0), cB, voffB); PG8_STAGE(PG8_SA(0, 0), cA, voffA); PG8_STAGE(PG8_SB(0, 1), cB + hstep, voffB); PG8_STAGE(PG8_SA(0, 1), cA + hstep, voffA);
        if (wr == 1) PG8_BAR;
        PG8_WAIT_V(4); PG8_BAR;
        PG8_STAGE(PG8_SB(1, 0), cB + kstep, voffB); PG8_STAGE(PG8_SA(1, 0), cA + kstep, voffA); PG8_STAGE(PG8_SB(1, 1), cB + hstep + kstep, voffB);
        PG8_WAIT_V(6); PG8_BAR;
    }
    for (;;) {
        const bool has_next = S.next(ui + 1, nxt);
        const char* nA = has_next ? (const char*)g.A + (size_t)nxt.pm * tstep : cA; const char* nB = has_next ? (const char*)g.Bt + (size_t)nxt.pn * tstep : cB;
        for (int t = 0; t < nt; t += 2) {
            const bool last = (t == nt - 2);
            const char* a1 = cA + (size_t)(t + 1) * kstep;
            const char* a2 = last ? nA : cA + (size_t)(t + 2) * kstep; const char* b2 = last ? nB : cB + (size_t)(t + 2) * kstep;
            const char* a3 = a2 + kstep; const char* b3 = b2 + kstep;
            if (last && has_next) S.a_ready(nxt);
            if constexpr (SP2) {
            PG8_LDB(B0, 0, 0); PG8_LDB(B1, 0, 1); PG8_SCHED; PG8_LDA(At, 0, 0); PG8_STAGE(PG8_SA(1, 1), a1 + hstep, voffA);
            PG8_WAIT_V(8); PG8_WAIT_L(0); PG8_BAR; PG8_MMA(0, 0, At, B0); PG8_MMA(0, 1, At, B1); PG8_BAR; PG8_SCHED;
            PG8_LDA(At, 0, 1); PG8_STAGE(PG8_SB(0, 0), b2, voffB); PG8_STAGE(PG8_SB(0, 1), b2 + hstep, voffB); PG8_STAGE(PG8_SA(0, 0), a2, voffA);
            PG8_WAIT_V(8); PG8_WAIT_L(0); PG8_BAR; PG8_MMA(1, 0, At, B0); PG8_MMA(1, 1, At, B1); PG8_BAR; PG8_SCHED;
            PG8_LDB(B0, 1, 0); PG8_LDB(B1, 1, 1); PG8_SCHED; PG8_LDA(At, 1, 0); PG8_STAGE(PG8_SA(0, 1), a2 + hstep, voffA);
            PG8_WAIT_V(8); PG8_WAIT_L(0); PG8_BAR; PG8_MMA(0, 0, At, B0); PG8_MMA(0, 1, At, B1); PG8_BAR; PG8_SCHED;
            PG8_LDA(At, 1, 1); PG8_STAGE(PG8_SB(1, 0), b3, voffB); PG8_STAGE(PG8_SB(1, 1), b3 + hstep, voffB); PG8_STAGE(PG8_SA(1, 0), a3, voffA);
            PG8_WAIT_V(8); PG8_WAIT_L(0); PG8_BAR; PG8_MMA(1, 0, At, B0); PG8_MMA(1, 1, At, B1); PG8_BAR; PG8_SCHED;
            } else {
            PG8_LDB(B0, 0, 0); PG8_SCHED; PG8_LDA(At, 0, 0); PG8_STAGE(PG8_SA(1, 1), a1 + hstep, voffA);
            PG8_WAIT_L(8); PG8_BAR; PG8_WAIT_L(0); PG8_MMA(0, 0, At, B0); PG8_BAR; PG8_SCHED;
            PG8_LDB(B1, 0, 1); PG8_STAGE(PG8_SB(0, 0), b2, voffB);
            PG8_BAR; PG8_WAIT_L(0); PG8_MMA(0, 1, At, B1); PG8_BAR;
            PG8_LDA(At, 0, 1); PG8_STAGE(PG8_SA(0, 0), a2, voffA);
            PG8_BAR; PG8_WAIT_L(0); PG8_MMA(1, 0, At, B0); PG8_BAR; PG8_SCHED;
            PG8_STAGE(PG8_SB(0, 1), b2 + hstep, voffB);
            PG8_WAIT_V(6); PG8_BAR; PG8_MMA(1, 1, At, B1); PG8_BAR;
            PG8_LDB(B0, 1, 0); PG8_SCHED; PG8_LDA(At, 1, 0); PG8_STAGE(PG8_SA(0, 1), a2 + hstep, voffA);
            PG8_WAIT_L(8); PG8_BAR; PG8_WAIT_L(0); PG8_MMA(0, 0, At, B0); PG8_BAR; PG8_SCHED;
            PG8_LDB(B1, 1, 1); PG8_STAGE(PG8_SB(1, 0), b3, voffB);
            PG8_BAR; PG8_WAIT_L(0); PG8_MMA(0, 1, At, B1); PG8_BAR;
            PG8_LDA(At, 1, 1); PG8_STAGE(PG8_SA(1, 0), a3, voffA);
            PG8_BAR; PG8_WAIT_L(0); PG8_MMA(1, 0, At, B0); PG8_BAR; PG8_SCHED;
            PG8_STAGE(PG8_SB(1, 1), b3 + hstep, voffB);
            PG8_WAIT_V(6); PG8_BAR; PG8_MMA(1, 1, At, B1); PG8_BAR;
            }
        }
        if constexpr (ALIGN_EPI) { if (wr == 0) PG8_BAR; }
        if constexpr (!Epi::AFTER_DRAIN) { E(acc, cur, wr, wc, fr, fq);
#ifdef REP_EPI
            if constexpr (Epi::PERM) { asm volatile("" ::: "memory"); E(acc, cur, wr, wc, fr, fq); }
#endif
            S.done(cur); }
        if (!has_next) break;
#pragma unroll
        for (int a = 0; a < 2; ++a)
#pragma unroll
            for (int b = 0; b < 2; ++b)
#pragma unroll
                for (int m = 0; m < 4; ++m)
#pragma unroll
                    for (int n = 0; n < 2; ++n) acc[a][b][m][n] = (f32x4){0.f, 0.f, 0.f, 0.f};
        cur = nxt; cA = nA; cB = nB; ++ui;
        if constexpr (ALIGN_EPI) { if (wr == 1) PG8_BAR; }
    }
    PG8_WAIT_V(0);
    if constexpr (!ALIGN_EPI) { if (wr == 0) PG8_BAR; }
    PG8_BAR;
    if constexpr (Epi::AFTER_DRAIN) { E.fused(acc, cur, wr, wc, fr, fq, lds, wid, lane); S.done(cur); }
#undef PG8_SA
#undef PG8_SB
#undef PG8_STAGE
#undef PG8_LDA
#undef PG8_LDB
#undef PG8_MMA
#undef PG8_WAIT_V
#undef PG8_WAIT_L
#undef PG8_BAR
#undef PG8_SCHED
}
}

#define LAS __attribute__((address_space(3)))
typedef unsigned short bf16;
typedef unsigned v4u __attribute__((ext_vector_type(4)));
typedef unsigned v2u __attribute__((ext_vector_type(2)));
typedef float f32x4 __attribute__((ext_vector_type(4)));
typedef float f32x2 __attribute__((ext_vector_type(2)));
typedef short bf16x8 __attribute__((ext_vector_type(8)));
typedef short s16x4 __attribute__((ext_vector_type(4)));
typedef short v4i16_t __attribute__((ext_vector_type(4)));
typedef __bf16 bf16x2_t __attribute__((ext_vector_type(2)));

constexpr int M_TOK = 16384, DM = 2048, FF = 8192, NPROJ = 6144, GLA_LD = 6160;
constexpr float EPS = 1e-6f, LOG2E = 1.4426950408889634f;
constexpr size_t MiB = 1u << 20;
constexpr size_t WS_SSQ = 0;
constexpr size_t WS_HSSQ = 256 * 1024;
constexpr size_t WS_WZT = 512 * 1024;
constexpr size_t WS_QK0 = 576 * 1024;
constexpr size_t WS_BAR = 704 * 1024;
constexpr size_t WS_DEC = 1 * MiB;
constexpr size_t WS_QK0P = 2 * MiB;
constexpr size_t WS_WIN = 4 * MiB, WS_WO = 28 * MiB, WS_WUP = 36 * MiB, WS_WDN = 68 * MiB;
constexpr size_t WS_XB = 100 * MiB;
constexpr size_t WS_U = 164 * MiB;
constexpr size_t WS_PROJ = 164 * MiB;
constexpr size_t WS_OG = 356 * MiB;
constexpr size_t WS_HPART = 420 * MiB;
constexpr size_t WS_END = 428 * MiB;
constexpr int LDS_BYTES = 147456;

#define LDS_WAIT() asm volatile("s_waitcnt lgkmcnt(0)" ::: "memory")
#define LBAR() do { asm volatile("s_waitcnt lgkmcnt(0)" ::: "memory"); __builtin_amdgcn_s_barrier(); asm volatile("" ::: "memory"); } while (0)

__device__ __forceinline__ unsigned pk2(float lo, float hi) { f32x2 v = {lo, hi}; bf16x2_t b = __builtin_convertvector(v, bf16x2_t); return __builtin_bit_cast(unsigned, b); }
__device__ __forceinline__ unsigned short f2bf(float f) { return (unsigned short)(pk2(f, 0.f) & 0xffffu); }
__device__ __forceinline__ float bflo(unsigned u) { return __uint_as_float(u << 16); }
__device__ __forceinline__ float bfhi(unsigned u) { return __uint_as_float(u & 0xffff0000u); }
__device__ __forceinline__ float wave_sum(float v) {
#pragma unroll
    for (int o = 1; o < 64; o <<= 1) v += __shfl_xor(v, o);
    return v;
}
__device__ __forceinline__ float dpp_sum16(float v) {
    v += __int_as_float(__builtin_amdgcn_update_dpp(0, __float_as_int(v), 0xB1, 0xF, 0xF, false));
    v += __int_as_float(__builtin_amdgcn_update_dpp(0, __float_as_int(v), 0x4E, 0xF, 0xF, false));
    v += __int_as_float(__builtin_amdgcn_update_dpp(0, __float_as_int(v), 0x141, 0xF, 0xF, false));
    v += __int_as_float(__builtin_amdgcn_update_dpp(0, __float_as_int(v), 0x140, 0xF, 0xF, false));
    return v;
}
__device__ __forceinline__ float xrow_sum(float v) {
    auto a = __builtin_amdgcn_permlane16_swap(__float_as_uint(v), __float_as_uint(v), false, false);
    v = __uint_as_float(a[0]) + __uint_as_float(a[1]);
    auto b = __builtin_amdgcn_permlane32_swap(__float_as_uint(v), __float_as_uint(v), false, false);
    return __uint_as_float(b[0]) + __uint_as_float(b[1]);
}
__device__ __forceinline__ float xrow_max(float v) {
    auto a = __builtin_amdgcn_permlane16_swap(__float_as_uint(v), __float_as_uint(v), false, false);
    v = fmaxf(__uint_as_float(a[0]), __uint_as_float(a[1]));
    auto b = __builtin_amdgcn_permlane32_swap(__float_as_uint(v), __float_as_uint(v), false, false);
    return fmaxf(__uint_as_float(b[0]), __uint_as_float(b[1]));
}
__device__ __forceinline__ s16x4 tr_read(const LAS unsigned char* p) { return __builtin_bit_cast(s16x4, __builtin_amdgcn_ds_read_tr16_b64_v4i16((LAS v4i16_t*)p)); }
__device__ __forceinline__ bf16x8 cat8(s16x4 a, s16x4 b) { return (bf16x8){a[0], a[1], a[2], a[3], b[0], b[1], b[2], b[3]}; }
__device__ __forceinline__ bf16x8 pack8(f32x4 a, f32x4 b) { v4u w; w.x = pk2(a[0], a[1]); w.y = pk2(a[2], a[3]); w.z = pk2(b[0], b[1]); w.w = pk2(b[2], b[3]); return __builtin_bit_cast(bf16x8, w); }
#define MFMA16(a, b, c) __builtin_amdgcn_mfma_f32_16x16x32_bf16((a), (b), (c), 0, 0, 0)

struct ConvTile { const float* src; const float* gk; bf16* dst; int ldw, K; };
__device__ __forceinline__ ConvTile conv_tile(int t, const float* Win, int ldwin, const float* gmix, const float* Wo, const float* Wup, const float* gmlp, const float* Wdn, unsigned char* ws) {
    constexpr int T_IN = 16 * 48, T_O = 16 * 16, T_UP = 16 * 64;
    ConvTile c;
    if (t < T_IN) { const int kb = t / 48, nb = t % 48; c.src = Win + (size_t)(128 * kb) * ldwin + 128 * nb; c.gk = gmix + 128 * kb; c.dst = (bf16*)(ws + WS_WIN) + (size_t)(128 * nb) * 2048 + 128 * kb; c.ldw = ldwin; c.K = 2048; return c; }
    t -= T_IN;
    if (t < T_O) { const int kb = t / 16, nb = t % 16; c.src = Wo + (size_t)(128 * kb) * 2048 + 128 * nb; c.gk = nullptr; c.dst = (bf16*)(ws + WS_WO) + (size_t)(128 * nb) * 2048 + 128 * kb; c.ldw = 2048; c.K = 2048; return c; }
    t -= T_O;
    if (t < T_UP) { const int kb = t / 64, nb = t % 64; c.src = Wup + (size_t)(128 * kb) * 8192 + 128 * nb; c.gk = gmlp + 128 * kb; c.dst = (bf16*)(ws + WS_WUP) + (size_t)(128 * nb) * 2048 + 128 * kb; c.ldw = 8192; c.K = 2048; return c; }
    t -= T_UP;
    { const int kb = t / 16, nb = t % 16; c.src = Wdn + (size_t)(128 * kb) * 2048 + 128 * nb; c.gk = nullptr; c.dst = (bf16*)(ws + WS_WDN) + (size_t)(128 * nb) * 8192 + 128 * kb; c.ldw = 2048; c.K = 8192; return c; }
}
__device__ __forceinline__ void convert_weights(const float* Win, int ldwin, const float* gmix, const float* Wo, const float* Wup, const float* gmlp, const float* Wdn,
                                                unsigned char* ws, LAS unsigned char* lds, int tid, int G) {
    asm volatile("" : "+v"(tid));
    constexpr int NT = 16 * 48 + 16 * 16 + 16 * 64 + 64 * 16;
    LAS float* scr = (LAS float*)lds;
    const int lr = tid >> 5, lc = (tid & 31) * 4;
    const int oc = tid & 15, on = tid >> 4;
    f32x4 r[8]; float gv[8];
    int t = blockIdx.x;
    if (t < NT) { const ConvTile c = conv_tile(t, Win, ldwin, gmix, Wo, Wup, gmlp, Wdn, ws);
#pragma unroll
        for (int i = 0; i < 8; ++i) { r[i] = __builtin_nontemporal_load((const f32x4*)(c.src + (size_t)(lr + 16 * i) * c.ldw + lc)); gv[i] = c.gk ? c.gk[lr + 16 * i] : 1.f; } }
    for (; t < NT; t += G) {
        const ConvTile c = conv_tile(t, Win, ldwin, gmix, Wo, Wup, gmlp, Wdn, ws);
        __syncthreads();
#pragma unroll
        for (int i = 0; i < 8; ++i) { LAS float* p = scr + (lr + 16 * i) * 129 + lc; p[0] = r[i][0] * gv[i]; p[1] = r[i][1] * gv[i]; p[2] = r[i][2] * gv[i]; p[3] = r[i][3] * gv[i]; }
        __syncthreads();
        if (t + G < NT) { const ConvTile cn = conv_tile(t + G, Win, ldwin, gmix, Wo, Wup, gmlp, Wdn, ws);
#pragma unroll
            for (int i = 0; i < 8; ++i) { r[i] = __builtin_nontemporal_load((const f32x4*)(cn.src + (size_t)(lr + 16 * i) * cn.ldw + lc)); gv[i] = cn.gk ? cn.gk[lr + 16 * i] : 1.f; } }
#pragma unroll
        for (int i = 0; i < 4; ++i) { const int n = on + 32 * i; const LAS float* sp = scr + (8 * oc) * 129 + n;
            v4u o; o.x = pk2(sp[0 * 129], sp[1 * 129]); o.y = pk2(sp[2 * 129], sp[3 * 129]); o.z = pk2(sp[4 * 129], sp[5 * 129]); o.w = pk2(sp[6 * 129], sp[7 * 129]);
            *(v4u*)(c.dst + (size_t)n * c.K + 8 * oc) = o; }
    }
    __syncthreads();
}

__device__ __forceinline__ float log_sigmoid(float x) { return fminf(x, 0.f) - __logf(1.f + __expf(-fabsf(x))); }
__device__ __forceinline__ void gla_prep(LAS unsigned char* lds, const bf16* xb, const bf16* WzT, const float* ssq0, const float* Wg, const float* bg, bf16* proj, float* dec,
                                         int tid, int lane, int w) {
    asm volatile("" : "+v"(tid), "+v"(lane)); asm volatile("" : "+s"(w));
    LAS float* zp = (LAS float*)lds;
    LAS float* zs = (LAS float*)(lds + 32768);
    const int g = lane >> 4, i16 = lane & 15;
    for (int unit = blockIdx.x; unit < 256; unit += gridDim.x) {
        const int tok0 = unit * 64;
        f32x4 za[4];
#pragma unroll
        for (int mt = 0; mt < 4; ++mt) za[mt] = (f32x4){0.f, 0.f, 0.f, 0.f};
#pragma unroll
        for (int ks = 0; ks < 8; ++ks) {
            const int k = w * 256 + ks * 32 + g * 8;
            const bf16x8 bf = *(const bf16x8*)(WzT + i16 * 2048 + k);
#pragma unroll
            for (int mt = 0; mt < 4; ++mt) { const bf16x8 af = *(const bf16x8*)(xb + (size_t)(tok0 + mt * 16 + i16) * 2048 + k); za[mt] = MFMA16(af, bf, za[mt]); }
        }
#pragma unroll
        for (int mt = 0; mt < 4; ++mt)
#pragma unroll
            for (int j = 0; j < 4; ++j) zp[(w * 64 + mt * 16 + 4 * g + j) * 16 + i16] = za[mt][j];
        __syncthreads();
#pragma unroll
        for (int e = 0; e < 2; ++e) { const int idx = tid + 512 * e, row = idx >> 4; float s = 0.f;
#pragma unroll
            for (int ww = 0; ww < 8; ++ww) s += zp[ww * 1024 + idx];
            zs[idx] = s * __builtin_amdgcn_rsqf(ssq0[tok0 + row] * (1.0f / 2048.0f) + EPS); }
        __syncthreads();
        const int c0 = 2 * tid;
        float wg0[16], wg1[16];
#pragma unroll
        for (int j = 0; j < 16; ++j) { const f32x2 t = *(const f32x2*)(Wg + j * 1024 + c0); wg0[j] = t.x; wg1[j] = t.y; }
        const f32x2 bgv = *(const f32x2*)(bg + c0);
        float b0 = 0.f, b1 = 0.f;
        unsigned* qp = (unsigned*)(proj + (size_t)tok0 * NPROJ + c0);
        unsigned q2[8], k2[8], q2n[8], k2n[8];
#pragma unroll
        for (int u = 0; u < 8; ++u) { const unsigned* p = qp + (size_t)u * (NPROJ / 2); q2[u] = p[0]; k2[u] = p[512]; }
        for (int t0 = 0; t0 < 64; t0 += 8) {
            if (t0 + 8 < 64) {
#pragma unroll
                for (int u = 0; u < 8; ++u) { const unsigned* p = qp + (size_t)(t0 + 8 + u) * (NPROJ / 2); q2n[u] = p[0]; k2n[u] = p[512]; }
            }
            asm volatile("" ::: "memory");
#pragma unroll
            for (int u = 0; u < 8; ++u) {
                const int t = t0 + u;
                float l0 = bgv.x, l1 = bgv.y;
#pragma unroll
                for (int j4 = 0; j4 < 4; ++j4) { const f32x4 z = *(const LAS f32x4*)(zs + t * 16 + j4 * 4);
#pragma unroll
                    for (int e = 0; e < 4; ++e) { l0 += z[e] * wg0[j4 * 4 + e]; l1 += z[e] * wg1[j4 * 4 + e]; } }
                b0 += log_sigmoid(l0) * (1.0f / 16.0f); b1 += log_sigmoid(l1) * (1.0f / 16.0f);
                unsigned* p = qp + (size_t)t * (NPROJ / 2);
                const float e0 = __expf(b0), e1 = __expf(b1), i0 = __expf(-b0), i1 = __expf(-b1);
                p[0] = pk2(bflo(q2[u]) * 0.0625f * e0, bfhi(q2[u]) * 0.0625f * e1);
                p[512] = pk2(bflo(k2[u]) * i0, bfhi(k2[u]) * i1);
            }
            asm volatile("" ::: "memory");
#pragma unroll
            for (int u = 0; u < 8; ++u) { q2[u] = q2n[u]; k2[u] = k2n[u]; }
        }
        *(f32x2*)(dec + (size_t)unit * 1024 + c0) = (f32x2){__expf(b0), __expf(b1)};
        __syncthreads();
    }
}

__device__ __forceinline__ void gla_scan(LAS unsigned char* lds, const bf16* proj, const float* dec, const float* qk0, const float* ssq0, bf16* og, float* hssq, int tid, int lane, int w) {
    asm volatile("" : "+v"(tid), "+v"(lane)); asm volatile("" : "+s"(w));
    constexpr int QS = 528, VS = 144, XS = 272;
    constexpr int QD = 0, KI = 33792, VV = 67584, AB = 76800, XO = 86016, DC = 103424;
    const int g = lane >> 4, i16 = lane & 15, dvt = w & 3, half = w >> 2;
    for (int unit = blockIdx.x; unit < 256; unit += gridDim.x) {
        const int xcd = unit & 7, uidx = unit >> 3, bh = xcd * 4 + (uidx >> 3), b = bh >> 2, h = bh & 3, js = uidx & 7;
        f32x4 S[8];
#pragma unroll
        for (int i = 0; i < 8; ++i) S[i] = (f32x4){0.f, 0.f, 0.f, 0.f};
        { float a00; f32x4 q4 = (f32x4){0.f, 0.f, 0.f, 0.f}, k4 = (f32x4){0.f, 0.f, 0.f, 0.f};
#pragma unroll
          for (int kq = 0; kq < 8; ++kq) { q4 = q4 + *(const f32x4*)(qk0 + (size_t)(kq * 8 + b) * 2048 + h * 256 + lane * 4); k4 = k4 + *(const f32x4*)(qk0 + (size_t)(kq * 8 + b) * 2048 + 1024 + h * 256 + lane * 4); }
          const float r2 = 1.0f / (ssq0[b * 2048] * (1.0f / 2048.0f) + EPS);
          a00 = wave_sum((q4[0] * k4[0] + q4[1] * k4[1]) + (q4[2] * k4[2] + q4[3] * k4[3])) * 0.0625f * r2;
          if (tid == 0) *(LAS float*)(lds + DC + 1024) = a00; }
        const int lrow = tid >> 5, lch = tid & 31, vrow = tid >> 3, vch = tid & 7;
        const bf16* pq = proj + (size_t)(b * 2048 + lrow) * NPROJ + h * 256 + lch * 8;
        const bf16* pv = proj + (size_t)(b * 2048 + vrow) * NPROJ + 2048 + h * 512 + js * 64 + vch * 8;
        const float* pd = dec + (size_t)(b * 32) * 1024 + h * 256 + (tid & 255);
        f32x4 ofin[2];
#pragma unroll
        for (int k = 0; k < 2; ++k) ofin[k] = (f32x4){0.f, 0.f, 0.f, 0.f};
#define SCAN_FLUSH(NP) do { const int tokb = b * 2048 + (NP) * 64; \
            _Pragma("unroll") for (int k = 0; k < 2; ++k) _Pragma("unroll") for (int j = 0; j < 4; ++j) { \
                const int c = (2 * half + k) * 16 + 4 * g + j; const float v = ofin[k][j]; \
                og[(size_t)(tokb + c) * DM + h * 512 + js * 64 + dvt * 16 + i16] = f2bf(v); \
                const float s = dpp_sum16(v * v); \
                if (i16 == 0) hssq[((size_t)(tokb + c) * 4 + h) * 32 + js * 4 + dvt] = s; } } while (0)
        v4u rq[4], rk[4], rv; float rd;
#pragma unroll
        for (int i = 0; i < 4; ++i) { rq[i] = *(const v4u*)(pq + (size_t)(16 * i) * NPROJ); rk[i] = *(const v4u*)(pq + (size_t)(16 * i) * NPROJ + 1024); }
        rv = *(const v4u*)pv; rd = pd[0];
        for (int n = 0; n < 32; ++n) {
            LBAR();
#pragma unroll
            for (int i = 0; i < 4; ++i) { *(LAS v4u*)(lds + QD + (lrow + 16 * i) * QS + lch * 16) = rq[i]; *(LAS v4u*)(lds + KI + (lrow + 16 * i) * QS + lch * 16) = rk[i]; }
            *(LAS v4u*)(lds + VV + vrow * VS + vch * 16) = rv;
            if (tid < 256) *(LAS float*)(lds + DC + tid * 4) = rd;
            LBAR();
            if (n + 1 < 32) {
                const size_t adv = (size_t)(n + 1) * 64 * NPROJ;
#pragma unroll
                for (int i = 0; i < 4; ++i) { rq[i] = *(const v4u*)(pq + adv + (size_t)(16 * i) * NPROJ); rk[i] = *(const v4u*)(pq + adv + (size_t)(16 * i) * NPROJ + 1024); }
                rv = *(const v4u*)(pv + adv); rd = pd[(n + 1) * 1024];
            }
            if (n > 0) { SCAN_FLUSH(n - 1); }
            {
                const int ct = w >> 1;
#pragma unroll
                for (int tt = 0; tt < 2; ++tt) {
                    const int st = (w & 1) * 2 + tt;
                    f32x4 a = (f32x4){0.f, 0.f, 0.f, 0.f};
                    if (st <= ct) {
                        bf16x8 af[8], bfr[8];
#pragma unroll
                        for (int ks = 0; ks < 8; ++ks) {
                            af[ks] = *(const LAS bf16x8*)(lds + QD + (ct * 16 + i16) * QS + ks * 64 + g * 16);
                            bfr[ks] = *(const LAS bf16x8*)(lds + KI + (st * 16 + i16) * QS + ks * 64 + g * 16);
                        }
                        asm volatile("" ::: "memory");
#pragma unroll
                        for (int ks = 0; ks < 8; ++ks) a = MFMA16(af[ks], bfr[ks], a);
                    }
#pragma unroll
                    for (int j = 0; j < 4; ++j) { const int c = ct * 16 + 4 * g + j, s = st * 16 + i16; float v = (s <= c) ? a[j] : 0.f;
                        if (n == 0 && c == 0 && s == 0) v = *(const LAS float*)(lds + DC + 1024);
                        *(LAS unsigned short*)(lds + AB + c * VS + s * 2) = f2bf(v); }
                }
            }
            f32x4 o[4];
#pragma unroll
            for (int ct = 0; ct < 4; ++ct) o[ct] = (f32x4){0.f, 0.f, 0.f, 0.f};
            {
                s16x4 qlo[4][4], qhi[4][4];
#pragma unroll
                for (int p = 0; p < 4; ++p) {
                    const int dkA = (half * 8 + 2 * p) * 16 + 4 * g;
#pragma unroll
                    for (int ct = 0; ct < 4; ++ct) {
                        qlo[p][ct] = *(const LAS s16x4*)(lds + QD + (ct * 16 + i16) * QS + dkA * 2);
                        qhi[p][ct] = *(const LAS s16x4*)(lds + QD + (ct * 16 + i16) * QS + (dkA + 16) * 2);
                    }
                }
                asm volatile("" ::: "memory");
#pragma unroll
                for (int p = 0; p < 4; ++p) {
                    const bf16x8 sf = pack8(S[2 * p], S[2 * p + 1]);
#pragma unroll
                    for (int ct = 0; ct < 4; ++ct) o[ct] = MFMA16(cat8(qlo[p][ct], qhi[p][ct]), sf, o[ct]);
                }
            }
            LBAR();
            bf16x8 vf0, vf1;
            { const LAS unsigned char* va = lds + VV + (8 * g + (i16 >> 2)) * VS + (dvt * 16 + 4 * (i16 & 3)) * 2;
              vf0 = cat8(tr_read(va), tr_read(va + 4 * VS)); vf1 = cat8(tr_read(va + 32 * VS), tr_read(va + 36 * VS)); }
            { const bf16x8 vh = half ? vf1 : vf0; bf16x8 af[4];
#pragma unroll
              for (int ct = 0; ct < 4; ++ct) af[ct] = *(const LAS bf16x8*)(lds + AB + (ct * 16 + i16) * VS + (half * 32 + 8 * g) * 2);
              asm volatile("" ::: "memory");
#pragma unroll
              for (int ct = 0; ct < 4; ++ct) o[ct] = MFMA16(af[ct], vh, o[ct]); }
#pragma unroll
            for (int ib = 0; ib < 2; ++ib) {
                s16x4 kt[4][4]; f32x4 dd[4];
#pragma unroll
                for (int ii = 0; ii < 4; ++ii) {
                    const int dk0 = (half * 8 + ib * 4 + ii) * 16;
                    const LAS unsigned char* ka = lds + KI + (8 * g + (i16 >> 2)) * QS + (dk0 + 4 * (i16 & 3)) * 2;
                    kt[ii][0] = tr_read(ka); kt[ii][1] = tr_read(ka + 4 * QS); kt[ii][2] = tr_read(ka + 32 * QS); kt[ii][3] = tr_read(ka + 36 * QS);
                    dd[ii] = *(const LAS f32x4*)(lds + DC + (dk0 + 4 * g) * 4);
                }
                asm volatile("" ::: "memory");
#pragma unroll
                for (int ii = 0; ii < 4; ++ii) {
                    const int i = ib * 4 + ii;
                    S[i] = MFMA16(cat8(kt[ii][0], kt[ii][1]), vf0, S[i]); S[i] = MFMA16(cat8(kt[ii][2], kt[ii][3]), vf1, S[i]);
                    S[i] = S[i] * dd[ii];
                }
            }
            {
                const f32x4 keep0 = half ? o[2] : o[0], keep1 = half ? o[3] : o[1], send0 = half ? o[0] : o[2], send1 = half ? o[1] : o[3];
                const int cs = (2 - 2 * half) * 16 + 4 * g, ck = (2 * half) * 16 + 4 * g;
#pragma unroll
                for (int j = 0; j < 4; ++j) { *(LAS float*)(lds + XO + (cs + j) * XS + (dvt * 16 + i16) * 4) = send0[j]; *(LAS float*)(lds + XO + (cs + 16 + j) * XS + (dvt * 16 + i16) * 4) = send1[j]; }
                LBAR();
#pragma unroll
                for (int j = 0; j < 4; ++j) { ofin[0][j] = keep0[j] + *(const LAS float*)(lds + XO + (ck + j) * XS + (dvt * 16 + i16) * 4);
                                              ofin[1][j] = keep1[j] + *(const LAS float*)(lds + XO + (ck + 16 + j) * XS + (dvt * 16 + i16) * 4); }
            }
        }
        { SCAN_FLUSH(31); }
        __syncthreads();
    }
#undef SCAN_FLUSH
}

__device__ __forceinline__ void gla_finalize(bf16* og, const bf16* proj, const float* hssq, const float* gout, int gtid, int nthr) {
    asm volatile("" : "+v"(gtid));
#define FIN_LOAD(IDX, ov, rv, rs, g0, g1) const int tok##IDX = (IDX) >> 8, c##IDX = ((IDX) & 255) * 8; \
        const v4u ov = *(const v4u*)(og + (size_t)tok##IDX * DM + c##IDX); const v4u rv = *(const v4u*)(proj + (size_t)tok##IDX * NPROJ + 4096 + c##IDX); \
        float hs##IDX = 0.f; { const f32x4* hp_ = (const f32x4*)(hssq + ((size_t)tok##IDX * 4 + (c##IDX >> 9)) * 32); \
          _Pragma("unroll") for (int q_ = 0; q_ < 8; ++q_) { const f32x4 t_ = hp_[q_]; hs##IDX += (t_[0] + t_[1]) + (t_[2] + t_[3]); } } \
        const float rs = __builtin_amdgcn_rsqf(hs##IDX * (1.0f / 512.0f) + EPS); \
        const f32x4 g0 = *(const f32x4*)(gout + c##IDX), g1 = *(const f32x4*)(gout + c##IDX + 4);
#define FIN_STORE(IDX, ov, rv, rs, g0, g1) { \
        float ovf[8] = {bflo(ov.x), bfhi(ov.x), bflo(ov.y), bfhi(ov.y), bflo(ov.z), bfhi(ov.z), bflo(ov.w), bfhi(ov.w)}; \
        float rvf[8] = {bflo(rv.x), bfhi(rv.x), bflo(rv.y), bfhi(rv.y), bflo(rv.z), bfhi(rv.z), bflo(rv.w), bfhi(rv.w)}; \
        float gg[8] = {g0[0], g0[1], g0[2], g0[3], g1[0], g1[1], g1[2], g1[3]}; float res[8]; \
        _Pragma("unroll") for (int e = 0; e < 8; ++e) { const float r = rvf[e]; res[e] = ovf[e] * rs * gg[e] * (r / (1.f + __expf(-r))); } \
        v4u w; w.x = pk2(res[0], res[1]); w.y = pk2(res[2], res[3]); w.z = pk2(res[4], res[5]); w.w = pk2(res[6], res[7]); \
        *(v4u*)(og + (size_t)tok##IDX * DM + c##IDX) = w; }
    for (int idx = gtid; idx < M_TOK * 256; idx += 4 * nthr) {
        const int idxa = idx, idxb = idx + nthr, idxc = idx + 2 * nthr, idxd = idx + 3 * nthr;
        FIN_LOAD(idxa, ova, rva, rsa, g0a, g1a)
        FIN_LOAD(idxb, ovb, rvb, rsb, g0b, g1b)
        FIN_LOAD(idxc, ovc, rvc, rsc, g0c, g1c)
        FIN_LOAD(idxd, ovd, rvd, rsd, g0d, g1d)
        asm volatile("" ::: "memory");
        FIN_STORE(idxa, ova, rva, rsa, g0a, g1a)
        FIN_STORE(idxb, ovb, rvb, rsb, g0b, g1b)
        FIN_STORE(idxc, ovc, rvc, rsc, g0c, g1c)
        FIN_STORE(idxd, ovd, rvd, rsd, g0d, g1d)
    }
#undef FIN_LOAD
#undef FIN_STORE
}

__device__ __forceinline__ void attn_phase(LAS unsigned char* lds, const bf16* qkv, const float* gq, const float* gk, const float* relb, bf16* ao, int tid, int lane, int w) {
    asm volatile("" : "+v"(tid), "+v"(lane)); asm volatile("" : "+s"(w));
    constexpr int KS = 272, VS = 288, KBUF = 64 * KS, VBUF = 64 * VS, VB0 = 2 * KBUF, BT = VB0 + 2 * VBUF;
    const int g = lane >> 4, i16 = lane & 15;
    const int srow = tid >> 4, sch = tid & 15;
    v4u qr[4], rk0, rk1, rv0, rv1;
#define ATT_U(UNIT) ((((UNIT) >> 7) < 2) ? (((UNIT) >> 7) ^ 1) : ((UNIT) >> 7))
#define ATT_QPTR(UNIT) (qkv + (size_t)((((UNIT) & 127) >> 4) * 2048 + (2 * ATT_U(UNIT) + (w >> 2)) * 64 + (w & 3) * 16 + i16) * NPROJ + ((UNIT) & 15) * 128 + g * 8)
#define ATT_KBASE(UNIT) (qkv + (size_t)((((UNIT) & 127) >> 4) * 2048 + srow) * NPROJ + 2048 + ((UNIT) & 15) * 128 + sch * 8)
#define ATT_KCLO(UNIT) ((2 * ATT_U(UNIT) - 8 > 0) ? (2 * ATT_U(UNIT) - 8) : 0)
#define ATT_LOADP(KB, kc) do { const bf16* p_ = (KB) + (size_t)(kc) * 64 * NPROJ; rk0 = *(const v4u*)p_; rk1 = *(const v4u*)(p_ + (size_t)32 * NPROJ); \
                          rv0 = *(const v4u*)(p_ + 2048); rv1 = *(const v4u*)(p_ + (size_t)32 * NPROJ + 2048); } while (0)
    if ((int)blockIdx.x < 2048) { const int un_ = blockIdx.x; const bf16* qp_ = ATT_QPTR(un_);
#pragma unroll
        for (int ks = 0; ks < 4; ++ks) qr[ks] = *(const v4u*)(qp_ + ks * 32);
        ATT_LOADP(ATT_KBASE(un_), ATT_KCLO(un_)); }
    int hprev = -1;
    f32x4 gqa[4], gqb[4];
#pragma unroll
    for (int ks = 0; ks < 4; ++ks) {
        gqa[ks] = *(const f32x4*)(gq + ks * 32 + g * 8) * *(const f32x4*)(gk + ks * 32 + g * 8) * (0.08838834764831845f * LOG2E);
        gqb[ks] = *(const f32x4*)(gq + ks * 32 + g * 8 + 4) * *(const f32x4*)(gk + ks * 32 + g * 8 + 4) * (0.08838834764831845f * LOG2E); }
    for (int unit = blockIdx.x; unit < 2048; unit += gridDim.x) {
        const int nunit = unit + (int)gridDim.x;
        const int u = ATT_U(unit), bh = unit & 127, b = bh >> 4, h = bh & 15;
        const int n0 = 2 * u, nq = n0 + (w >> 2);
        if (h != hprev) { if (tid < 320) *(LAS float*)(lds + BT + tid * 4) = relb[h * 320 + tid] * LOG2E; hprev = h; }
        bf16x8 qf[4];
        {
            float ss = 0.f;
#pragma unroll
            for (int ks = 0; ks < 4; ++ks) {
                const float a0 = bflo(qr[ks].x), a1 = bfhi(qr[ks].x), a2 = bflo(qr[ks].y), a3 = bfhi(qr[ks].y), a4 = bflo(qr[ks].z), a5 = bfhi(qr[ks].z), a6 = bflo(qr[ks].w), a7 = bfhi(qr[ks].w);
                ss += (a0 * a0 + a1 * a1) + (a2 * a2 + a3 * a3) + (a4 * a4 + a5 * a5) + (a6 * a6 + a7 * a7); }
            ss = xrow_sum(ss);
            const float rs = __builtin_amdgcn_rsqf(ss * (1.0f / 128.0f) + EPS);
#pragma unroll
            for (int ks = 0; ks < 4; ++ks) {
                const f32x4 ga = gqa[ks], gb = gqb[ks];
                v4u o; o.x = pk2(bflo(qr[ks].x) * rs * ga[0], bfhi(qr[ks].x) * rs * ga[1]); o.y = pk2(bflo(qr[ks].y) * rs * ga[2], bfhi(qr[ks].y) * rs * ga[3]);
                o.z = pk2(bflo(qr[ks].z) * rs * gb[0], bfhi(qr[ks].z) * rs * gb[1]); o.w = pk2(bflo(qr[ks].w) * rs * gb[2], bfhi(qr[ks].w) * rs * gb[3]);
                qf[ks] = __builtin_bit_cast(bf16x8, o);
            }
        }
        const int kc_lo = (n0 - 8 > 0) ? (n0 - 8) : 0, ntiles = n0 + 2 - kc_lo;
        const bf16* kbase = qkv + (size_t)(b * 2048 + srow) * NPROJ + 2048 + h * 128 + sch * 8;
#define ATT_LOAD(kc) do { const bf16* p_ = kbase + (size_t)(kc) * 64 * NPROJ; rk0 = *(const v4u*)p_; rk1 = *(const v4u*)(p_ + (size_t)32 * NPROJ); \
                          rv0 = *(const v4u*)(p_ + 2048); rv1 = *(const v4u*)(p_ + (size_t)32 * NPROJ + 2048); } while (0)
#define ATT_KNORM(r, dstrow, buf) do { \
            const float a0 = bflo(r.x), a1 = bfhi(r.x), a2 = bflo(r.y), a3 = bfhi(r.y), a4 = bflo(r.z), a5 = bfhi(r.z), a6 = bflo(r.w), a7 = bfhi(r.w); \
            float s_ = (a0 * a0 + a1 * a1) + (a2 * a2 + a3 * a3) + (a4 * a4 + a5 * a5) + (a6 * a6 + a7 * a7); \
            s_ = dpp_sum16(s_); \
            const float rs_ = __builtin_amdgcn_rsqf(s_ * (1.0f / 128.0f) + EPS); v4u o_; \
            o_.x = pk2(a0 * rs_, a1 * rs_); o_.y = pk2(a2 * rs_, a3 * rs_); o_.z = pk2(a4 * rs_, a5 * rs_); o_.w = pk2(a6 * rs_, a7 * rs_); \
            *(LAS v4u*)(lds + (buf) * KBUF + (dstrow) * KS + sch * 16) = o_; } while (0)
#define ATT_WRITE(buf) do { ATT_KNORM(rk0, srow, buf); ATT_KNORM(rk1, srow + 32, buf); \
            *(LAS v4u*)(lds + VB0 + (buf) * VBUF + srow * VS + sch * 16) = rv0; *(LAS v4u*)(lds + VB0 + (buf) * VBUF + (srow + 32) * VS + sch * 16) = rv1; } while (0)
        ATT_WRITE(0);
        ATT_LOAD(kc_lo + 1);
        LBAR();
        f32x4 OT[8];
#pragma unroll
        for (int dt = 0; dt < 8; ++dt) OT[dt] = (f32x4){0.f, 0.f, 0.f, 0.f};
        float mrun = -1e30f, lrun = 0.f;
        const int qi = (w & 3) * 16 + i16;
        for (int t = 0; t < ntiles; ++t) {
            const int kc = kc_lo + t, buf = t & 1;
            if (t + 1 < ntiles) ATT_WRITE(buf ^ 1);
            if (t + 2 < ntiles) ATT_LOAD(kc + 2);
            if (t == ntiles - 1 && nunit < 2048) { const bf16* qp_ = ATT_QPTR(nunit);
#pragma unroll
                for (int ks = 0; ks < 4; ++ks) qr[ks] = *(const v4u*)(qp_ + ks * 32);
                ATT_LOADP(ATT_KBASE(nunit), ATT_KCLO(nunit)); }
            if (kc >= nq - 8 && kc <= nq) {
                const LAS unsigned char* Kb = lds + buf * KBUF;
                const LAS unsigned char* Vb = lds + VB0 + buf * VBUF;
                f32x4 s[4];
                {
                    bf16x8 kf[4][4];
#pragma unroll
                    for (int kt = 0; kt < 4; ++kt)
#pragma unroll
                        for (int ks = 0; ks < 4; ++ks) kf[kt][ks] = *(const LAS bf16x8*)(Kb + (kt * 16 + i16) * KS + ks * 64 + g * 16);
                    asm volatile("" ::: "memory");
#pragma unroll
                    for (int kt = 0; kt < 4; ++kt) s[kt] = (f32x4){0.f, 0.f, 0.f, 0.f};
#pragma unroll
                    for (int ks = 0; ks < 4; ++ks)
#pragma unroll
                        for (int kt = 0; kt < 4; ++kt) s[kt] = MFMA16(kf[kt][ks], qf[ks], s[kt]);
                }
                const int dchunk = nq - kc;
                if (dchunk >= 5) {
                    const float bc = *(const LAS float*)(lds + BT + 319 * 4);
#pragma unroll
                    for (int kt = 0; kt < 4; ++kt) s[kt] = s[kt] + bc;
                } else if (dchunk <= 3) {
                    const LAS float* bp = (const LAS float*)(lds + BT) + (dchunk * 64 + qi - 4 * g + 12);
#pragma unroll
                    for (int kt = 0; kt < 4; ++kt)
#pragma unroll
                        for (int j = 0; j < 4; ++j) s[kt][j] += bp[51 - kt * 16 - j];
                } else {
                    const int dbase = dchunk * 64 + qi - 4 * g + 63;
#pragma unroll
                    for (int kt = 0; kt < 4; ++kt)
#pragma unroll
                        for (int j = 0; j < 4; ++j) { int idx = dbase - kt * 16 - j; idx = idx < 0 ? 0 : (idx > 319 ? 319 : idx); s[kt][j] += *(const LAS float*)(lds + BT + idx * 4); }
                }
                float mx = fmaxf(fmaxf(s[0][0], s[0][1]), fmaxf(s[0][2], s[0][3]));
#pragma unroll
                for (int kt = 1; kt < 4; ++kt) mx = fmaxf(mx, fmaxf(fmaxf(s[kt][0], s[kt][1]), fmaxf(s[kt][2], s[kt][3])));
                mx = xrow_max(mx);
                const float mnew = fmaxf(mrun, mx), alpha = __builtin_amdgcn_exp2f(mrun - mnew);
                mrun = mnew;
                float rsum = 0.f;
#pragma unroll
                for (int kt = 0; kt < 4; ++kt)
#pragma unroll
                    for (int j = 0; j < 4; ++j) { const float p = __builtin_amdgcn_exp2f(s[kt][j] - mnew); s[kt][j] = p; rsum += p; }
                rsum = xrow_sum(rsum);
                lrun = lrun * alpha + rsum;
#pragma unroll
                for (int dt = 0; dt < 8; ++dt) OT[dt] = OT[dt] * alpha;
                const bf16x8 pf0 = pack8(s[0], s[1]), pf1 = pack8(s[2], s[3]);
                const LAS unsigned char* va = Vb + (4 * g + (i16 >> 2)) * VS + (4 * (i16 & 3)) * 2;
#pragma unroll
                for (int db = 0; db < 2; ++db) {
                    s16x4 vt[4][4];
#pragma unroll
                    for (int dd = 0; dd < 4; ++dd) { const int dt = db * 4 + dd;
                        vt[dd][0] = tr_read(va + dt * 32); vt[dd][1] = tr_read(va + 16 * VS + dt * 32); vt[dd][2] = tr_read(va + 32 * VS + dt * 32); vt[dd][3] = tr_read(va + 48 * VS + dt * 32); }
                    asm volatile("" ::: "memory");
#pragma unroll
                    for (int dd = 0; dd < 4; ++dd) { const int dt = db * 4 + dd;
                        OT[dt] = MFMA16(cat8(vt[dd][0], vt[dd][1]), pf0, OT[dt]); OT[dt] = MFMA16(cat8(vt[dd][2], vt[dd][3]), pf1, OT[dt]); }
                }
            }
            LBAR();
        }
        {
            const float inv = 1.0f / lrun;
            bf16* op = ao + (size_t)(b * 2048 + nq * 64 + qi) * DM + h * 128 + 4 * g;
#pragma unroll
            for (int dt = 0; dt < 8; ++dt) { v2u o; o.x = pk2(OT[dt][0] * inv, OT[dt][1] * inv); o.y = pk2(OT[dt][2] * inv, OT[dt][3] * inv); *(v2u*)(op + dt * 16) = o; }
        }
    }
#undef ATT_LOAD
#undef ATT_LOADP
#undef ATT_QPTR
#undef ATT_U
#undef ATT_KBASE
#undef ATT_KCLO
#undef ATT_KNORM
#undef ATT_WRITE
}

#define RLX_AGENT __ATOMIC_RELAXED, __HIP_MEMORY_SCOPE_AGENT
#define XB_TMO      128
#define XB_XCNT(j)  (256  + 64 * (j))
#define XB_XSUB(j)  (1280 + 64 * (j))
#define XB_XGEN(j)  (2304 + 64 * (j))
#define XB_TOP      3328
#define XB_TOPGEN   3392
#define XCD_BAR_WORDS 3456
#define XB_SPIN_CAP (1u << 18)

__device__ __forceinline__ unsigned xb_ld(unsigned* p)              { return __hip_atomic_load(p, __ATOMIC_RELAXED, __HIP_MEMORY_SCOPE_AGENT); }
__device__ __forceinline__ unsigned xb_add(unsigned* p, unsigned v) { return __hip_atomic_fetch_add(p, v, __ATOMIC_RELAXED, __HIP_MEMORY_SCOPE_AGENT); }
__device__ __forceinline__ unsigned xb_xcc_id() { return (unsigned)__builtin_amdgcn_s_getreg((3 << 11) | 20) & 0xFu; }
#define XB_SPIN(cond, bar) do { unsigned _sp = 0; while (cond) { __builtin_amdgcn_s_sleep(1); \
    if ((++_sp & 255u) == 0u) { if (xb_ld(&(bar)[XB_TMO])) break; if (_sp > XB_SPIN_CAP) { atomicAdd(&(bar)[XB_TMO], 1u); break; } } } } while (0)

struct XcdBarrier {
    unsigned* bar; unsigned x;
    volatile LAS unsigned* st;
};

__device__ __forceinline__ XcdBarrier xcd_barrier_post(unsigned* bar, volatile LAS unsigned* st) {
    XcdBarrier b; b.bar = bar; b.x = xb_xcc_id(); b.st = st;
    if (threadIdx.x == 0) (void)xb_add(&bar[XB_XCNT(b.x)], 1u);
    return b;
}
__device__ __forceinline__ void xcd_barrier_complete(unsigned* bar, unsigned x, unsigned& nloc, unsigned& nx) {
    const unsigned G = gridDim.x * gridDim.y * gridDim.z;
    unsigned sum, cnt, mine, sp = 0u;
    for (;;) {
        sum = 0u; cnt = 0u; mine = 0u;
#pragma unroll
        for (unsigned j = 0; j < 16; ++j) { const unsigned c = xb_ld(&bar[XB_XCNT(j)]); sum += c; cnt += (c > 0u) ? 1u : 0u; mine = (j == x) ? c : mine; }
        if (sum == G) break;
        __builtin_amdgcn_s_sleep(1);
        if ((++sp & 255u) == 0u) { if (xb_ld(&bar[XB_TMO])) break; if (sp > XB_SPIN_CAP) { atomicAdd(&bar[XB_TMO], 1u); break; } }
    }
    nloc = mine > 0u ? mine : 1u; nx = cnt > 0u ? cnt : 1u;
}

__device__ __forceinline__ void xcd_barrier(const XcdBarrier& b) {
    asm volatile("s_waitcnt vmcnt(0)" ::: "memory");
    __syncthreads();
    if (threadIdx.x == 0) {
        unsigned* bar = b.bar;
        __builtin_amdgcn_s_waitcnt(0);
        unsigned nloc = b.st[0], nx = b.st[1];
        if (nloc == 0u) { xcd_barrier_complete(bar, b.x, nloc, nx); b.st[0] = nloc; b.st[1] = nx; }
        const unsigned old = xb_add(&bar[XB_XSUB(b.x)], 1u);
        const unsigned gen = old / nloc;
        if (old + 1u == (gen + 1u) * nloc) {
            __builtin_amdgcn_fence(__ATOMIC_RELEASE, "agent");
            asm volatile("s_waitcnt vmcnt(0)" ::: "memory");
            const unsigned og = xb_add(&bar[XB_TOP], 1u);
            const unsigned tg = og / nx;
            if (og + 1u == (tg + 1u) * nx) xb_add(&bar[XB_TOPGEN], 1u);
            else XB_SPIN(xb_ld(&bar[XB_TOPGEN]) == tg, bar);
            __builtin_amdgcn_fence(__ATOMIC_ACQUIRE, "agent");
            xb_add(&bar[XB_XGEN(b.x)], 1u);
            asm volatile("s_waitcnt vmcnt(0)" ::: "memory");
        } else {
            XB_SPIN(xb_ld(&bar[XB_XGEN(b.x)]) == gen, bar);
            __builtin_amdgcn_fence(__ATOMIC_ACQUIRE, "agent");
            asm volatile("s_waitcnt vmcnt(0)" ::: "memory");
        }
    }
    __syncthreads();
}

struct Args { const float* in[15]; float* out; unsigned char* ws; };
typedef const __attribute__((address_space(4))) unsigned char* kptr_t;
__device__ __forceinline__ kptr_t kfresh(kptr_t p) { asm volatile("" : "+s"(p)); return p; }
#define KIN(i) (*(const float* const __attribute__((address_space(4)))*)(kfresh(kargp) + 8 * (i)))
#define KOUT() ((float*)*(const float* const __attribute__((address_space(4)))*)(kfresh(kargp) + 120))
#define KWS() ((unsigned char*)*(const float* const __attribute__((address_space(4)))*)(kfresh(kargp) + 128))
__global__ void __launch_bounds__(512, 2) mega_fwd(Args args) {
    extern __shared__ __attribute__((aligned(16))) unsigned char lds_raw[];
    cg::grid_group grid = cg::this_grid();
    LAS unsigned char* lds = (LAS unsigned char*)lds_raw;
    const kptr_t kargp = (kptr_t)__builtin_amdgcn_kernarg_segment_ptr();
#define PHASE_IDS() int tid = threadIdx.x; asm volatile("" : "+v"(tid)); const int lane = tid & 63, wave = __builtin_amdgcn_readfirstlane(tid >> 6); \
    const int gw = blockIdx.x * 8 + wave, gtid = blockIdx.x * 512 + tid; (void)lane; (void)wave; (void)gw; (void)gtid;
    if (threadIdx.x < 4) ((volatile LAS unsigned*)(lds + 140000))[threadIdx.x] = 0u;
    __syncthreads();
    const XcdBarrier xbar = xcd_barrier_post((unsigned*)(KWS() + WS_BAR), (volatile LAS unsigned*)(lds + 140000));
#define GSYNC() xcd_barrier(xbar)
    const int G = gridDim.x, NGW = G * 8, nthr = G * 512;

#pragma unroll
    for (int L = 0; L < 2; ++L) {
        if (L == 0) {
            PHASE_IDS()
            unsigned char* ws = KWS();
            const float* Win = KIN(3); const float* gm = KIN(1); const float* x = KIN(0);
#ifdef REP_CONV
            int reps = 2; asm volatile("" : "+s"(reps));
            for (int rep = 0; rep < reps; ++rep)
#endif
            convert_weights(Win, GLA_LD, gm, KIN(7), KIN(13), KIN(2), KIN(14), ws, lds, tid, G);
            bf16* WzT = (bf16*)(ws + WS_WZT); float* ssq = (float*)(ws + WS_SSQ); float* hssq = (float*)(ws + WS_HSSQ); bf16* xb = (bf16*)(ws + WS_XB);
            for (int i = gtid; i < 16 * 2048; i += nthr) { const int j = i >> 11, k = i & 2047; WzT[j * 2048 + k] = f2bf(Win[(size_t)k * GLA_LD + 6144 + j] * gm[k]); }
            for (int i = gtid; i < 3 * 16384; i += nthr) ssq[16384 + i] = 0.f;
            for (int m = gw; m < M_TOK; m += 2 * NGW) {
                const int m2 = m + NGW;
                const f32x4* xr = (const f32x4*)(x + (size_t)m * DM) + lane; const f32x4* xr2 = (const f32x4*)(x + (size_t)m2 * DM) + lane;
                f32x4 v[8], v2[8]; float s = 0.f, s2 = 0.f;
#pragma unroll
                for (int j = 0; j < 8; ++j) v[j] = __builtin_nontemporal_load(xr + 64 * j);
#pragma unroll
                for (int j = 0; j < 8; ++j) v2[j] = __builtin_nontemporal_load(xr2 + 64 * j);
#pragma unroll
                for (int j = 0; j < 8; ++j) { s += (v[j].x * v[j].x + v[j].y * v[j].y) + (v[j].z * v[j].z + v[j].w * v[j].w); s2 += (v2[j].x * v2[j].x + v2[j].y * v2[j].y) + (v2[j].z * v2[j].z + v2[j].w * v2[j].w); }
                s = wave_sum(s); s2 = wave_sum(s2); if (lane == 0) { ssq[m] = s; ssq[m2] = s2; }
                unsigned long long* o8 = (unsigned long long*)(xb + (size_t)m * DM) + lane; unsigned long long* o82 = (unsigned long long*)(xb + (size_t)m2 * DM) + lane;
#pragma unroll
                for (int j = 0; j < 8; ++j) { o8[64 * j] = (unsigned long long)pk2(v[j].x, v[j].y) | ((unsigned long long)pk2(v[j].z, v[j].w) << 32);
                                              o82[64 * j] = (unsigned long long)pk2(v2[j].x, v2[j].y) | ((unsigned long long)pk2(v2[j].z, v2[j].w) << 32); }
            }
            __syncthreads();
            for (int u = blockIdx.x; u < 256; u += G) {
                const int cgp = u & 31, kq = u >> 5;
                LAS float* xs = (LAS float*)lds;
                for (int i = tid; i < 2048; i += 512) { const int bb = i >> 8, kk = i & 255; xs[i] = x[(size_t)bb * 2048 * DM + kq * 256 + kk] * gm[kq * 256 + kk]; }
                __syncthreads();
                const int col = cgp * 64 + lane;
                const float* wp = Win + (size_t)(kq * 256) * GLA_LD + col;
                float acc = 0.f;
#pragma unroll 32
                for (int k = 0; k < 256; ++k) acc += xs[wave * 256 + k] * wp[(size_t)k * GLA_LD];
                ((float*)(ws + WS_QK0P))[(size_t)(kq * 8 + wave) * 2048 + col] = acc;
                __syncthreads();
            }
        } else {
            PHASE_IDS()
            convert_weights(KIN(8), NPROJ, KIN(1) + DM, KIN(12), KIN(13) + (size_t)DM * FF, KIN(2) + DM, KIN(14) + (size_t)FF * DM, KWS(), lds, tid, G);
        }
        __syncthreads();
        if (G > 0x3fffffff) grid.sync();
        GSYNC();
#ifdef REP_SYNC
        for (int rep = 0; rep < 5; ++rep) GSYNC();
#endif
        {
            unsigned char* ws = KWS();
            pg8::Gemm gm{(const bf16*)(ws + WS_XB), (const bf16*)(ws + WS_WIN), M_TOK, NPROJ, DM}; pg8::StaticOrder S; S.init(M_TOK, NPROJ, G, (int)blockIdx.x);
            pg8::EpiBf16S<0> E{(bf16*)(ws + WS_PROJ), NPROJ, (const float*)(ws + WS_SSQ) + (L == 0 ? 0 : 2 * 16384)};
#ifdef REP_INPROJ
            int reps = 2; asm volatile("" : "+s"(reps));
            for (int rep = 0; rep < reps; ++rep)
#endif
            pg8::gemm_phase<pg8::EpiBf16S<0>, pg8::StaticOrder, true, true>(lds, gm, S, E);
        }
        GSYNC();
        if (L == 0) {
            { PHASE_IDS() unsigned char* ws = KWS();
              gla_prep(lds, (const bf16*)(ws + WS_XB), (const bf16*)(ws + WS_WZT), (const float*)(ws + WS_SSQ), KIN(4), KIN(5), (bf16*)(ws + WS_PROJ), (float*)(ws + WS_DEC), tid, lane, wave);
            }
            GSYNC();
            { PHASE_IDS() unsigned char* ws = KWS();
#ifdef REP_SCAN
              int reps = 2; asm volatile("" : "+s"(reps));
              for (int rep = 0; rep < reps; ++rep)
              gla_scan(lds, (const bf16*)(ws + WS_PROJ), (const float*)(ws + WS_DEC), (const float*)(ws + WS_QK0P), (const float*)(ws + WS_SSQ), (bf16*)(ws + WS_OG), (float*)(ws + (rep == 0 ? WS_HPART : WS_END)), tid, lane, wave);
#else
              gla_scan(lds, (const bf16*)(ws + WS_PROJ), (const float*)(ws + WS_DEC), (const float*)(ws + WS_QK0P), (const float*)(ws + WS_SSQ), (bf16*)(ws + WS_OG), (float*)(ws + WS_HPART), tid, lane, wave);
#endif
            }
            GSYNC();
            { PHASE_IDS() unsigned char* ws = KWS();
              gla_finalize((bf16*)(ws + WS_OG), (const bf16*)(ws + WS_PROJ), (const float*)(ws + WS_HPART), KIN(6), gtid, nthr);
            }
        } else {
            PHASE_IDS()
            unsigned char* ws = KWS();
#ifdef REP_ATTN
            int reps = 2; asm volatile("" : "+s"(reps));
            for (int rep = 0; rep < reps; ++rep)
#endif
            attn_phase(lds, (const bf16*)(ws + WS_PROJ), KIN(9), KIN(10), KIN(11), (bf16*)(ws + WS_OG), tid, lane, wave);
        }
        __syncthreads();
        GSYNC();
        {
            unsigned char* ws = KWS(); float* out = KOUT();
            pg8::Gemm gm{(const bf16*)(ws + WS_OG), (const bf16*)(ws + WS_WO), M_TOK, DM, DM}; pg8::StaticOrder S; S.init(M_TOK, DM, G, (int)blockIdx.x);
            pg8::EpiRes E{(bf16*)(ws + WS_XB), out, (float*)(ws + WS_SSQ) + (L == 0 ? 1 : 3) * 16384, DM, 0};
            pg8::gemm_phase<pg8::EpiRes, pg8::StaticOrder, false, true>(lds, gm, S, E);
        }
        GSYNC();
        {
            unsigned char* ws = KWS();
            pg8::Gemm gm{(const bf16*)(ws + WS_XB), (const bf16*)(ws + WS_WUP), M_TOK, FF, DM}; pg8::StaticOrder S; S.init(M_TOK, FF, G, (int)blockIdx.x);
            pg8::EpiBf16S<1> E{(bf16*)(ws + WS_U), FF, (const float*)(ws + WS_SSQ) + (L == 0 ? 1 : 3) * 16384};
#ifdef REP_UP
            int reps = 2; asm volatile("" : "+s"(reps));
            for (int rep = 0; rep < reps; ++rep)
#endif
            pg8::gemm_phase<pg8::EpiBf16S<1>, pg8::StaticOrder, true, true>(lds, gm, S, E);
        }
        GSYNC();
        {
            unsigned char* ws = KWS(); float* out = KOUT();
            pg8::Gemm gm{(const bf16*)(ws + WS_U), (const bf16*)(ws + WS_WDN), M_TOK, DM, FF}; pg8::StaticOrder S; S.init(M_TOK, DM, G, (int)blockIdx.x, 4);
            pg8::EpiRes E{(bf16*)(ws + WS_XB), out, (float*)(ws + WS_SSQ) + 2 * 16384, DM, L == 0 ? 0 : 1};
            pg8::gemm_phase<pg8::EpiRes, pg8::StaticOrder, false, true>(lds, gm, S, E);
        }
        if (L == 0) GSYNC();
    }
}

extern "C" void kernel_launch(void* const* d_in, const int* in_sizes, int n_in, void* d_out, int out_size, void* d_ws, size_t ws_size, hipStream_t stream) {
    static int grid = 0;
    if (grid == 0) {
        if (n_in != 15 || out_size != M_TOK * DM || ws_size < WS_END) { fprintf(stderr, "kernel_launch: unexpected shapes (n_in %d, out %d, ws %zu)\n", n_in, out_size, ws_size); grid = -1; return; }
        int dev = 0, cus = 0, per_cu = 0;
        (void)hipGetDevice(&dev);
        (void)hipDeviceGetAttribute(&cus, hipDeviceAttributeMultiprocessorCount, dev);
        (void)hipFuncSetAttribute((const void*)mega_fwd, hipFuncAttributeMaxDynamicSharedMemorySize, LDS_BYTES);
        (void)hipOccupancyMaxActiveBlocksPerMultiprocessor(&per_cu, (const void*)mega_fwd, 512, LDS_BYTES);
        if (per_cu < 1) per_cu = 1;
        if (cus < 1) cus = 256;
        (void)hipGetLastError();
        grid = cus * per_cu;
    }
    if (grid < 0) return;
    if (hipMemsetAsync((char*)d_ws + WS_BAR, 0, 16384, stream) != hipSuccess) { fprintf(stderr, "kernel_launch: memset failed\n"); return; }
    Args a{};
    for (int i = 0; i < 15; ++i) a.in[i] = (const float*)d_in[i];
    a.out = (float*)d_out; a.ws = (unsigned char*)d_ws;
    void* kargs[] = {&a};
    hipError_t e = hipLaunchCooperativeKernel((const void*)mega_fwd, dim3(grid), dim3(512), kargs, LDS_BYTES, stream);
    if (e != hipSuccess) fprintf(stderr, "cooperative launch failed: %s (grid %d)\n", hipGetErrorString(e), grid);
}
```
